# Optimizing an MI355X kernel written in HIP

```python
import math
import jax, jax.numpy as jnp
from jax import lax
import numpy as np

D_MODEL = 2048
BATCH = 4
SEQ = 2048
DEPTH = 2
DEC_BATCH = 128
DEC_SEQ = 8
PAST_LEN = 16384
PAGE_SIZE = 128

HEAD_DIM = 128
H_A = 6
H_B = 6
H_C = 4
W_A = H_A * HEAD_DIM
W_B = H_B * HEAD_DIM
W_C = H_C * HEAD_DIM
MIX = W_A + W_B + W_C
N_HEADS_ALL = H_A + H_B + H_C
N_META = 16
CONV_W = 4
CHUNK_A = 64
CHUNK_B = 64
CHUNK_C = 16
EPS = 1e-6
NEG_BIG = -1e30
EXP_CLIP = 60.0
SPLIT_SIZES = (W_A, W_A, W_A, W_A, H_A, H_A,
               W_B, W_B, W_B, H_B, H_B,
               W_C, W_C, W_C,
               MIX)
SPLIT_POINTS = tuple(int(s) for s in np.cumsum(SPLIT_SIZES)[:-1])
N_IN = int(sum(SPLIT_SIZES))

kernel_name = 'hymba_mlstm_gdn_hgrn2_step'


def _rmsnorm(x, w):
    xf = x.astype(jnp.float32)
    y = xf * lax.rsqrt(jnp.mean(xf * xf, axis=-1, keepdims=True) + EPS)
    return (y * w.astype(jnp.float32)).astype(x.dtype)


def _to_chunks(x, c):
    b, l = x.shape[:2]
    x = x.reshape((b, l // c, c) + x.shape[2:])
    return jnp.swapaxes(jnp.moveaxis(x, 1, 0), 2, 3)


def _from_chunks(x):
    nc, b, h, c = x.shape[:4]
    x = jnp.moveaxis(jnp.swapaxes(x, 2, 3), 0, 1)
    return x.reshape((b, nc * c) + x.shape[3:])


def _mlstm_segment(q, k, v, i_pre, f_pre, state, chunk):
    c = math.gcd(q.shape[1], chunk)
    qc = _to_chunks(q, c)
    kc = _to_chunks(k * (HEAD_DIM ** -0.5), c)
    vc = _to_chunks(v, c)
    lic = _to_chunks(i_pre, c)
    lfc = _to_chunks(jax.nn.log_sigmoid(f_pre), c)
    causal = jnp.tril(jnp.ones((c, c), dtype=bool))

    def step(carry, inp):
        C, n, m = carry
        q_, k_, v_, li, lf = inp
        F = jnp.cumsum(lf, axis=-1)
        Dm = jnp.where(causal, F[..., :, None] - F[..., None, :] + li[..., None, :], NEG_BIG)
        inter = F + m[..., None]
        mt = jnp.maximum(inter, jnp.max(Dm, axis=-1))
        a = jnp.exp(inter - mt)
        P = jnp.exp(Dm - mt[..., None]) * jnp.einsum('bhtd,bhsd->bhts', q_, k_)
        num = a[..., None] * jnp.einsum('bhtd,bhde->bhte', q_, C) + jnp.einsum('bhts,bhse->bhte', P, v_)
        den = a * jnp.einsum('bhtd,bhd->bht', q_, n) + jnp.sum(P, axis=-1)
        h = num / jnp.maximum(jnp.abs(den), jnp.exp(jnp.minimum(-mt, EXP_CLIP)))[..., None]
        m_new = mt[..., -1]
        a_s = jnp.exp(F[..., -1] + m - m_new)
        w = jnp.exp(F[..., -1:] - F + li - m_new[..., None])
        C_new = a_s[..., None, None] * C + jnp.einsum('bhs,bhsd,bhse->bhde', w, k_, v_)
        n_new = a_s[..., None] * n + jnp.einsum('bhs,bhsd->bhd', w, k_)
        return (C_new, n_new, m_new), h

    new_state, h = lax.scan(step, state, (qc, kc, vc, lic, lfc))
    return _from_chunks(h), new_state


def _gdn_segment(q, k, v, g, beta, S0, chunk):
    c = math.gcd(q.shape[1], chunk)
    qc, kc, vc = _to_chunks(q, c), _to_chunks(k, c), _to_chunks(v, c)
    gc, bc = _to_chunks(g, c), _to_chunks(beta, c)
    G = jnp.cumsum(gc, axis=-1)
    incl = jnp.tril(jnp.ones((c, c), dtype=bool))
    strict = jnp.tril(jnp.ones((c, c), dtype=bool), -1)
    decay = jnp.exp(jnp.where(incl, G[..., :, None] - G[..., None, :], NEG_BIG))
    A = jnp.where(strict, bc[..., None] * decay * jnp.einsum('nbhtd,nbhsd->nbhts', kc, kc), 0.0)
    M = A + jnp.eye(c, dtype=A.dtype)
    rhs = jnp.concatenate([bc[..., None] * vc, (bc * jnp.exp(G))[..., None] * kc], axis=-1)
    sol = lax.linalg.triangular_solve(M, rhs, left_side=True, lower=True)
    U, Wk = sol[..., :HEAD_DIM], sol[..., HEAD_DIM:]
    Aqk = decay * jnp.einsum('nbhtd,nbhsd->nbhts', qc, kc)

    def step(S, inp):
        q_, k_, U_, Wk_, Aqk_, G_ = inp
        W = U_ - jnp.einsum('bhtd,bhde->bhte', Wk_, S)
        o = jnp.exp(G_)[..., None] * jnp.einsum('bhtd,bhde->bhte', q_, S) + jnp.einsum('bhts,bhse->bhte', Aqk_, W)
        Ge = G_[..., -1:]
        S_new = jnp.exp(Ge)[..., None] * S + jnp.einsum('bhsd,bhse->bhde', k_ * jnp.exp(Ge - G_)[..., None], W)
        return S_new, o

    S_new, o = lax.scan(step, S0, (qc, kc, U, Wk, Aqk, G))
    return _from_chunks(o), S_new


def _hgrn_segment(q, k, v, logf, S0, chunk):
    c = math.gcd(q.shape[1], chunk)
    qc, kc, vc = _to_chunks(q, c), _to_chunks(k, c), _to_chunks(v, c)
    bcum = jnp.cumsum(_to_chunks(logf, c), axis=-2)
    incl = jnp.tril(jnp.ones((c, c), dtype=bool))[..., None]

    def step(S, inp):
        q_, k_, v_, b_ = inp
        diff = jnp.where(incl, b_[..., :, None, :] - b_[..., None, :, :], NEG_BIG)
        A = jnp.einsum('bhtd,bhsd,bhtsd->bhts', q_, k_, jnp.exp(diff))
        o = jnp.einsum('bhtd,bhde->bhte', q_ * jnp.exp(b_), S) + jnp.einsum('bhts,bhse->bhte', A, v_)
        be = b_[..., -1:, :]
        S_new = jnp.exp(be[..., 0, :])[..., None] * S + jnp.einsum('bhsd,bhse->bhde', k_ * jnp.exp(be - b_), v_)
        return S_new, o

    S_new, o = lax.scan(step, S0, (qc, kc, vc, bcum))
    return _from_chunks(o), S_new


def _l2norm(x):
    return x * lax.rsqrt(jnp.sum(x * x, axis=-1, keepdims=True) + EPS)


def _layer(x, state, seg_lens, norm_w, w_in, mlstm_b, A_log, dt_bias, conv_w, lb, out_norm_w, w_out):
    f32 = jnp.float32
    C_a, n_a, m_a, S_b, conv_b, S_c = state
    bsz, L, _ = x.shape
    h = _rmsnorm(x, norm_w)
    proj = jnp.einsum('bld,de->ble', h, w_in)
    (aq, ak, av, ao, ai, af, bq, bk, bv, ba, bb, cq, cf, ci, z) = jnp.split(proj, SPLIT_POINTS, axis=-1)

    def heads(t, nh):
        return t.astype(f32).reshape(bsz, L, nh, HEAD_DIM)

    mlstm_b = mlstm_b.astype(f32)
    qa, ka, va = heads(aq, H_A), heads(ak, H_A), heads(av, H_A)
    i_pre = ai.astype(f32) + mlstm_b[0]
    f_pre = af.astype(f32) + mlstm_b[1]
    u = jnp.concatenate([bq, bk, bv], axis=-1)
    u_ext = jnp.concatenate([conv_b.astype(u.dtype), u], axis=1)
    conv = u_ext[:, 0:L].astype(f32) * conv_w[0].astype(f32)
    for j in range(1, CONV_W):
        conv = conv + u_ext[:, j:j + L].astype(f32) * conv_w[j].astype(f32)
    conv = jax.nn.silu(conv)
    new_conv = u_ext[:, -(CONV_W - 1):]
    qb = _l2norm(heads(conv[..., :W_B], H_B)) * (HEAD_DIM ** -0.5)
    kb = _l2norm(heads(conv[..., W_B:2 * W_B], H_B))
    vb = heads(conv[..., 2 * W_B:], H_B)
    g_b = -jnp.exp(A_log.astype(f32)) * jax.nn.softplus(ba.astype(f32) + dt_bias.astype(f32))
    beta_b = jax.nn.sigmoid(bb.astype(f32))
    lbh = lb.reshape(H_C, HEAD_DIM)
    cfh = heads(cf, H_C)
    logf_c = jax.nn.log_sigmoid(cfh) + jnp.log1p(lbh * jnp.exp(jnp.minimum(-cfh, EXP_CLIP)))
    kc = (1.0 - lbh) * jax.nn.sigmoid(-cfh)
    qc = jax.nn.silu(heads(cq, H_C))
    vc = heads(ci, H_C)

    st_a = (C_a.astype(f32), n_a.astype(f32), m_a.astype(f32))
    st_b = S_b.astype(f32)
    st_c = S_c.astype(f32)
    outs_a, outs_b, outs_c = [], [], []
    off = 0
    for ls in seg_lens:
        sl = slice(off, off + ls)
        o, st_a = _mlstm_segment(qa[:, sl], ka[:, sl], va[:, sl], i_pre[:, sl], f_pre[:, sl], st_a, CHUNK_A)
        outs_a.append(o)
        o, st_b = _gdn_segment(qb[:, sl], kb[:, sl], vb[:, sl], g_b[:, sl], beta_b[:, sl], st_b, CHUNK_B)
        outs_b.append(o)
        o, st_c = _hgrn_segment(qc[:, sl], kc[:, sl], vc[:, sl], logf_c[:, sl], st_c, CHUNK_C)
        outs_c.append(o)
        off += ls
    ha = jnp.concatenate(outs_a, axis=1) * jax.nn.sigmoid(heads(ao, H_A))
    hb = jnp.concatenate(outs_b, axis=1)
    hc = jnp.concatenate(outs_c, axis=1)
    hcat = jnp.concatenate([ha, hb, hc], axis=2)
    hcat = hcat * lax.rsqrt(jnp.mean(hcat * hcat, axis=-1, keepdims=True) + EPS)
    y = hcat.reshape(bsz, L, MIX) * out_norm_w.astype(f32) * jax.nn.silu(z.astype(f32))
    out = jnp.einsum('ble,ed->bld', y.astype(x.dtype), w_out)
    return x + out, (st_a[0], st_a[1], st_a[2], st_b, new_conv, st_c)


def _zero_state(bsz, dtype):
    f32 = jnp.float32
    return (jnp.zeros((bsz, H_A, HEAD_DIM, HEAD_DIM), f32), jnp.zeros((bsz, H_A, HEAD_DIM), f32),
            jnp.zeros((bsz, H_A), f32), jnp.zeros((bsz, H_B, HEAD_DIM, HEAD_DIM), f32),
            jnp.zeros((bsz, CONV_W - 1, 3 * W_B), dtype), jnp.zeros((bsz, H_C, HEAD_DIM, HEAD_DIM), f32))


def setup_inputs(seed: int = 0) -> dict:
    key = jax.random.key(seed)
    ks = jax.random.split(key, 24)
    f32 = jnp.float32

    def nrm(k, shape, s):
        return jax.random.normal(k, shape, f32) * s

    dt = jnp.exp(jax.random.uniform(ks[13], (DEPTH, H_B), f32, math.log(1e-3), math.log(1e-1)))
    mlstm_gate_b = jnp.stack([nrm(ks[10], (DEPTH, H_A), 0.1),
                              jax.random.uniform(ks[11], (DEPTH, H_A), f32, 3.0, 6.0)], axis=1)
    return {
        'x_prompt': nrm(ks[0], (BATCH, SEQ, D_MODEL), 1.0),
        'x_sample': nrm(ks[1], (DEC_BATCH, DEC_SEQ, D_MODEL), 1.0),
        'state_mlstm_C': nrm(ks[2], (DEPTH, DEC_BATCH, H_A, HEAD_DIM, HEAD_DIM), HEAD_DIM ** -0.5),
        'state_mlstm_n': nrm(ks[3], (DEPTH, DEC_BATCH, H_A, HEAD_DIM), HEAD_DIM ** -0.5),
        'state_mlstm_m': nrm(ks[4], (DEPTH, DEC_BATCH, H_A), 1.0),
        'state_gdn_S': nrm(ks[5], (DEPTH, DEC_BATCH, H_B, HEAD_DIM, HEAD_DIM), 0.5),
        'state_gdn_conv': nrm(ks[6], (DEPTH, DEC_BATCH, CONV_W - 1, 3 * W_B), 1.0),
        'state_hgrn_S': nrm(ks[7], (DEPTH, DEC_BATCH, H_C, HEAD_DIM, HEAD_DIM), 1.0),
        'meta_tokens': nrm(ks[8], (N_META, D_MODEL), 1.0),
        'norm_w': 1.0 + nrm(ks[9], (DEPTH, D_MODEL), 0.1),
        'w_in': nrm(ks[12], (DEPTH, D_MODEL, N_IN), D_MODEL ** -0.5),
        'mlstm_gate_b': mlstm_gate_b,
        'gdn_A_log': jnp.log(jax.random.uniform(ks[14], (DEPTH, H_B), f32, 1.0, 16.0)),
        'gdn_dt_bias': dt + jnp.log(-jnp.expm1(-dt)),
        'gdn_conv_w': nrm(ks[15], (DEPTH, CONV_W, 3 * W_B), CONV_W ** -0.5),
        'hgrn_lower_bounds': nrm(ks[16], (DEPTH, W_C), 1.0),
        'out_norm_w': 1.0 + nrm(ks[17], (DEPTH, MIX), 0.1),
        'w_out': nrm(ks[18], (DEPTH, MIX, D_MODEL), MIX ** -0.5),
        'final_norm_w': 1.0 + nrm(ks[19], (D_MODEL,), 0.1),
    }


def reference(x_prompt, x_sample, state_mlstm_C, state_mlstm_n, state_mlstm_m, state_gdn_S, state_gdn_conv,
              state_hgrn_S, meta_tokens, norm_w, w_in, mlstm_gate_b, gdn_A_log, gdn_dt_bias, gdn_conv_w,
              hgrn_lower_bounds, out_norm_w, w_out, final_norm_w):
    bsz, seq_len, _ = x_prompt.shape
    dec_seq = x_sample.shape[1]
    sm = jax.nn.softmax(hgrn_lower_bounds.astype(jnp.float32), axis=0)
    lb_all = jnp.cumsum(sm, axis=0) - sm[0]
    meta = jnp.broadcast_to(meta_tokens.astype(x_prompt.dtype)[None], (bsz, N_META, D_MODEL))
    xp = jnp.concatenate([meta, x_prompt], axis=1)
    xs = x_sample
    new_p = [[] for _ in range(6)]
    new_s = [[] for _ in range(6)]
    for l in range(DEPTH):
        params = (norm_w[l], w_in[l], mlstm_gate_b[l], gdn_A_log[l], gdn_dt_bias[l], gdn_conv_w[l], lb_all[l],
                  out_norm_w[l], w_out[l])
        xp, st_p = _layer(xp, _zero_state(bsz, xp.dtype), (N_META, seq_len), *params)
        past = (state_mlstm_C[l], state_mlstm_n[l], state_mlstm_m[l], state_gdn_S[l], state_gdn_conv[l],
                state_hgrn_S[l])
        xs, st_s = _layer(xs, past, (dec_seq,), *params)
        for j in range(6):
            new_p[j].append(st_p[j])
            new_s[j].append(st_s[j])
    y_prompt = _rmsnorm(xp[:, N_META:], final_norm_w)
    y_sample = _rmsnorm(xs, final_norm_w)
    mC_p, mn_p, mm_p, gS_p, gc_p, hS_p = [jnp.stack(a, axis=0) for a in new_p]
    mC_s, mn_s, mm_s, gS_s, gc_s, hS_s = [jnp.stack(a, axis=0) for a in new_s]
    return (y_prompt, y_sample, mC_p, mn_p, mm_p, gS_p, gc_p, hS_p, mC_s, mn_s, mm_s, gS_s, gc_s, hS_s)
```

```cpp
#include <hip/hip_runtime.h>
#include <cstdio>
#include <cstdint>

#ifndef MK_PER_PHASE
#define MK_PER_PHASE 1
#endif

namespace pg8 {
#define PG8_LAS __attribute__((address_space(3)))
typedef unsigned short bf16_t;
typedef short bf16x8 __attribute__((ext_vector_type(8)));
typedef float f32x4 __attribute__((ext_vector_type(4)));
typedef unsigned u32x4 __attribute__((ext_vector_type(4)));
constexpr int BM = 256, BK = 64, HALF = 128, HTB = HALF * BK * 2  , STAGE_BYTES = 8 * HTB, NXCD = 8, WGM = 8;

__host__ __device__ __forceinline__ int lds_byte(int r, int c) { const int st = (r >> 4) * 2 + (c >> 5), rr = r & 15, cc = c & 31, ob = rr * 64 + cc * 2; return st * 1024 + (ob ^ (((ob >> 9) & 1) << 5)); }
__host__ __device__ __forceinline__ void stage_rc(int b, int& R, int& C) { const int st = b / 1024, sb = b % 1024, swz = sb ^ (((sb >> 9) & 1) << 5); R = (st >> 1) * 16 + swz / 64; C = (st & 1) * 32 + (swz % 64) / 2; }
__host__ __device__ __forceinline__ int perm32(int rho) { const int n = rho >> 4, i = rho & 15; return 8 * (i >> 2) + 4 * n + (i & 3); }

struct Unit { int pm, pn; };
struct Gemm { const bf16_t* A; const bf16_t* Bt; int M, N, K; };

struct StaticOrder {
    int nM, nN, nwg, G, c;
    __host__ __device__ void init(int M, int N, int G_, int c_) { nM = M / BM; nN = N / BM; nwg = nM * nN; G = G_; c = c_; }
    __host__ __device__ bool next(int i, Unit& u) const {
        const long L = (long)i * G + c; if (L >= nwg) return false;
        int wgid = (int)L; { const int q = nwg / NXCD, r = nwg % NXCD, xcd = wgid % NXCD, off = wgid / NXCD; wgid = (xcd < r ? xcd * (q + 1) : r * (q + 1) + (xcd - r) * q) + off; }
        const int nig = WGM * nN, gid = wgid / nig, fm = gid * WGM, gsz = (nM - fm) < WGM ? (nM - fm) : WGM;
        u.pm = fm + ((wgid % nig) % gsz); u.pn = (wgid % nig) / gsz; return true;
    }
    __device__ __forceinline__ void a_ready(const Unit&) const {}
    __device__ __forceinline__ void done(const Unit&) const {}
};

__device__ __forceinline__ unsigned cvt_pk_bf16(float lo, float hi) { unsigned r; asm volatile("v_cvt_pk_bf16_f32 %0, %1, %2" : "=v"(r) : "v"(lo), "v"(hi)); return r; }

struct EpiBf16 {
    static constexpr bool PERM = true, AFTER_DRAIN = false;
    bf16_t* O; int ldc;
    __device__ __forceinline__ void operator()(const f32x4 (&acc)[2][2][4][2], const Unit& u, int wr, int wc, int fr, int fq) const {
        const int row0 = u.pm * BM + wr * 64 + fr; const int col0 = u.pn * BM + wc * 32 + 8 * fq;
#pragma unroll
        for (int ai = 0; ai < 2; ++ai)
#pragma unroll
            for (int m = 0; m < 4; ++m) { bf16_t* rowp = O + (size_t)(row0 + ai * HALF + m * 16) * ldc + col0;
#pragma unroll
                for (int bj = 0; bj < 2; ++bj) { const f32x4 v0 = acc[ai][bj][m][0], v1 = acc[ai][bj][m][1];
                    u32x4 w; w.x = cvt_pk_bf16(v0[0], v0[1]); w.y = cvt_pk_bf16(v0[2], v0[3]); w.z = cvt_pk_bf16(v1[0], v1[1]); w.w = cvt_pk_bf16(v1[2], v1[3]);
                    *(u32x4*)(rowp + bj * HALF) = w; } }
    }
};
struct EpiRes {
    static constexpr bool PERM = false, AFTER_DRAIN = false;
    float* X; const float* xp; const float* meta; const float* xs; int first; int mrows;
    __device__ __forceinline__ const float* src_row(int r) const {
        if (!first) return X + (size_t)r * 2048;
        if (r >= 8256) return xs + (size_t)(r - 8256) * 2048;
        const int b = r / 2064, t = r - b * 2064;
        return t < 16 ? meta + (size_t)t * 2048 : xp + ((size_t)b * 2048 + (t - 16)) * 2048;
    }
    __device__ __forceinline__ void operator()(const f32x4 (&acc)[2][2][4][2], const Unit& u, int wr, int wc, int fr, int fq) const {
        const int row0 = u.pm * BM + wr * 64 + fr, col0 = u.pn * BM + wc * 32 + 4 * fq;
#pragma unroll
        for (int ai = 0; ai < 2; ++ai)
#pragma unroll
            for (int m = 0; m < 4; ++m) { const int row = row0 + ai * HALF + m * 16;
                if (row < mrows) { const float* sp = src_row(row) + col0; float* dp = X + (size_t)row * 2048 + col0;
#pragma unroll
                    for (int bj = 0; bj < 2; ++bj)
#pragma unroll
                        for (int n = 0; n < 2; ++n) *(f32x4*)(dp + bj * HALF + n * 16) = *(const f32x4*)(sp + bj * HALF + n * 16) + acc[ai][bj][m][n]; } }
    }
};

template <class Epi, class Sched, bool ALIGN_EPI = false, bool SP2 = false>
__device__ __forceinline__ void gemm_phase(PG8_LAS unsigned char* lds, const Gemm g, const Sched& S, const Epi& E) {
    const int tid = threadIdx.x, wid = __builtin_amdgcn_readfirstlane(tid >> 6), lane = tid & 63, wr = wid >> 2, wc = wid & 3, fr = lane & 15, fq = lane >> 4;
    const int K = g.K, nt = K / BK;
    unsigned voffA[2], voffB[2];
#pragma unroll
    for (int i = 0; i < 2; ++i) { int R, C; stage_rc(tid * 16 + i * 8192, R, C); const int Rb = Epi::PERM ? ((R & ~31) + perm32(R & 31)) : R;
        voffA[i] = (unsigned)(R * K + C) * 2u; voffB[i] = (unsigned)(Rb * K + C) * 2u; }
    const size_t kstep = (size_t)(BK * 2);
    const size_t hstep = (size_t)HALF * K * 2;
    const size_t tstep = 2 * hstep;
    const unsigned ldsw = (unsigned)wid * 1024u;
    const int aoff = lds_byte(wr * 64 + fr, fq * 8), boff = lds_byte(wc * 32 + fr, fq * 8);
#define PG8_SA(b, h) (((b) * 2 + (h)) * HTB)
#define PG8_SB(b, h) ((4 + (b) * 2 + (h)) * HTB)
#define PG8_STAGE(bufoff, gbase, voff) do { _Pragma("unroll") for (int _i = 0; _i < 2; ++_i) \
        __builtin_amdgcn_global_load_lds((const unsigned*)((const char*)(gbase) + (voff)[_i]), (PG8_LAS unsigned*)(lds + (bufoff) + ldsw + _i * 8192), 16, 0, 0); } while (0)
#define PG8_LDA(dst, b, h) do { _Pragma("unroll") for (int m = 0; m < 4; ++m) _Pragma("unroll") for (int k = 0; k < 2; ++k) dst[m][k] = *(const PG8_LAS bf16x8*)(lds + PG8_SA(b, h) + aoff + m * 2048 + k * 1024); } while (0)
#define PG8_LDB(dst, b, h) do { _Pragma("unroll") for (int n = 0; n < 2; ++n) _Pragma("unroll") for (int k = 0; k < 2; ++k) dst[n][k] = *(const PG8_LAS bf16x8*)(lds + PG8_SB(b, h) + boff + n * 2048 + k * 1024); } while (0)
#define PG8_MMA(ai, bj, At, Bt) do { __builtin_amdgcn_s_setprio(1); _Pragma("unroll") for (int m = 0; m < 4; ++m) _Pragma("unroll") for (int n = 0; n < 2; ++n) _Pragma("unroll") for (int k = 0; k < 2; ++k) \
        acc[ai][bj][m][n] = __builtin_amdgcn_mfma_f32_16x16x32_bf16(Bt[n][k], At[m][k], acc[ai][bj][m][n], 0, 0, 0); __builtin_amdgcn_s_setprio(0); } while (0)
#define PG8_WAIT_V(n) asm volatile("s_waitcnt vmcnt(" #n ")" ::: "memory")
#define PG8_WAIT_L(n) asm volatile("s_waitcnt lgkmcnt(" #n ")" ::: "memory")
#define PG8_BAR __builtin_amdgcn_s_barrier()
#define PG8_SCHED __builtin_amdgcn_sched_barrier(0)
    Unit cur, nxt; int ui = 0;
    if (!S.next(0, cur)) return;
    f32x4 acc[2][2][4][2];
#pragma unroll
    for (int a = 0; a < 2; ++a)
#pragma unroll
        for (int b = 0; b < 2; ++b)
#pragma unroll
            for (int m = 0; m < 4; ++m)
#pragma unroll
                for (int n = 0; n < 2; ++n) acc[a][b][m][n] = (f32x4){0.f, 0.f, 0.f, 0.f};
    bf16x8 At[4][2], B0[2][2], B1[2][2];
    const char* cA = (const char*)g.A + (size_t)cur.pm * tstep; const char* cB = (const char*)g.Bt + (size_t)cur.pn * tstep;
    S.a_ready(cur);
    if constexpr (SP2) {
        PG8_STAGE(PG8_SB(0, 0), cB, voffB); PG8_STAGE(PG8_SB(0, 1), cB + hstep, voffB); PG8_STAGE(PG8_SA(0, 0), cA, voffA); PG8_STAGE(PG8_SA(0, 1), cA + hstep, voffA);
        if (wr == 1) PG8_BAR;
        PG8_WAIT_V(2); PG8_BAR;
        PG8_STAGE(PG8_SB(1, 0), cB + kstep, voffB); PG8_STAGE(PG8_SA(1, 0), cA + kstep, voffA); PG8_STAGE(PG8_SB(1, 1), cB + hstep + kstep, voffB);
        PG8_WAIT_V(6); PG8_BAR;
    } else {
        PG8_STAGE(PG8_SB(0, 0), cB, voffB); PG8_STAGE(PG8_SA(0, 0), cA, voffA); PG8_STAGE(PG8_SB(0, 1), cB + hstep, voffB); PG8_STAGE(PG8_SA(0, 1), cA + hstep, voffA);
        if (wr == 1) PG8_BAR;
        PG8_WAIT_V(4); PG8_BAR;
        PG8_STAGE(PG8_SB(1, 0), cB + kstep, voffB); PG8_STAGE(PG8_SA(1, 0), cA + kstep, voffA); PG8_STAGE(PG8_SB(1, 1), cB + hstep + kstep, voffB);
        PG8_WAIT_V(6); PG8_BAR;
    }
    for (;;) {
        const bool has_next = S.next(ui + 1, nxt);
        const char* nA = has_next ? (const char*)g.A + (size_t)nxt.pm * tstep : cA; const char* nB = has_next ? (const char*)g.Bt + (size_t)nxt.pn * tstep : cB;
        for (int t = 0; t < nt; t += 2) {
            const bool last = (t == nt - 2);
            const char* a1 = cA + (size_t)(t + 1) * kstep;
            const char* a2 = last ? nA : cA + (size_t)(t + 2) * kstep; const char* b2 = last ? nB : cB + (size_t)(t + 2) * kstep;
            const char* a3 = a2 + kstep; const char* b3 = b2 + kstep;
            if (last && has_next) S.a_ready(nxt);
            if constexpr (SP2) {
            PG8_LDB(B0, 0, 0); PG8_LDB(B1, 0, 1); PG8_SCHED; PG8_LDA(At, 0, 0); PG8_STAGE(PG8_SA(1, 1), a1 + hstep, voffA);
            PG8_WAIT_V(8); PG8_WAIT_L(0); PG8_BAR; PG8_MMA(0, 0, At, B0); PG8_MMA(0, 1, At, B1); PG8_BAR; PG8_SCHED;
            PG8_LDA(At, 0, 1); PG8_STAGE(PG8_SB(0, 0), b2, voffB); PG8_STAGE(PG8_SB(0, 1), b2 + hstep, voffB); PG8_STAGE(PG8_SA(0, 0), a2, voffA);
            PG8_WAIT_V(8); PG8_WAIT_L(0); PG8_BAR; PG8_MMA(1, 0, At, B0); PG8_MMA(1, 1, At, B1); PG8_BAR; PG8_SCHED;
            PG8_LDB(B0, 1, 0); PG8_LDB(B1, 1, 1); PG8_SCHED; PG8_LDA(At, 1, 0); PG8_STAGE(PG8_SA(0, 1), a2 + hstep, voffA);
            PG8_WAIT_V(8); PG8_WAIT_L(0); PG8_BAR; PG8_MMA(0, 0, At, B0); PG8_MMA(0, 1, At, B1); PG8_BAR; PG8_SCHED;
            PG8_LDA(At, 1, 1); PG8_STAGE(PG8_SB(1, 0), b3, voffB); PG8_STAGE(PG8_SB(1, 1), b3 + hstep, voffB); PG8_STAGE(PG8_SA(1, 0), a3, voffA);
            PG8_WAIT_V(8); PG8_WAIT_L(0); PG8_BAR; PG8_MMA(1, 0, At, B0); PG8_MMA(1, 1, At, B1); PG8_BAR; PG8_SCHED;
            } else {
            PG8_LDB(B0, 0, 0); PG8_SCHED; PG8_LDA(At, 0, 0); PG8_STAGE(PG8_SA(1, 1), a1 + hstep, voffA);
            PG8_WAIT_L(8); PG8_BAR; PG8_WAIT_L(0); PG8_MMA(0, 0, At, B0); PG8_BAR; PG8_SCHED;
            PG8_LDB(B1, 0, 1); PG8_STAGE(PG8_SB(0, 0), b2, voffB);
            PG8_BAR; PG8_WAIT_L(0); PG8_MMA(0, 1, At, B1); PG8_BAR;
            PG8_LDA(At, 0, 1); PG8_STAGE(PG8_SA(0, 0), a2, voffA);
            PG8_BAR; PG8_WAIT_L(0); PG8_MMA(1, 0, At, B0); PG8_BAR; PG8_SCHED;
            PG8_STAGE(PG8_SB(0, 1), b2 + hstep, voffB);
            PG8_WAIT_V(6); PG8_BAR; PG8_MMA(1, 1, At, B1); PG8_BAR;
            PG8_LDB(B0, 1, 0); PG8_SCHED; PG8_LDA(At, 1, 0); PG8_STAGE(PG8_SA(0, 1), a2 + hstep, voffA);
            PG8_WAIT_L(8); PG8_BAR; PG8_WAIT_L(0); PG8_MMA(0, 0, At, B0); PG8_BAR; PG8_SCHED;
            PG8_LDB(B1, 1, 1); PG8_STAGE(PG8_SB(1, 0), b3, voffB);
            PG8_BAR; PG8_WAIT_L(0); PG8_MMA(0, 1, At, B1); PG8_BAR;
            PG8_LDA(At, 1, 1); PG8_STAGE(PG8_SA(1, 0), a3, voffA);
            PG8_BAR; PG8_WAIT_L(0); PG8_MMA(1, 0, At, B0); PG8_BAR; PG8_SCHED;
            PG8_STAGE(PG8_SB(1, 1), b3 + hstep, voffB);
            PG8_WAIT_V(6); PG8_BAR; PG8_MMA(1, 1, At, B1); PG8_BAR;
            }
        }
        if constexpr (ALIGN_EPI) { if (wr == 0) PG8_BAR; }
        if constexpr (!Epi::AFTER_DRAIN) { E(acc, cur, wr, wc, fr, fq); S.done(cur); }
        if (!has_next) break;
#pragma unroll
        for (int a = 0; a < 2; ++a)
#pragma unroll
            for (int b = 0; b < 2; ++b)
#pragma unroll
                for (int m = 0; m < 4; ++m)
#pragma unroll
                    for (int n = 0; n < 2; ++n) acc[a][b][m][n] = (f32x4){0.f, 0.f, 0.f, 0.f};
        cur = nxt; cA = nA; cB = nB; ++ui;
        if constexpr (ALIGN_EPI) { if (wr == 1) PG8_BAR; }
    }
    PG8_WAIT_V(0);
    if constexpr (!ALIGN_EPI) { if (wr == 0) PG8_BAR; }
    PG8_BAR;
    if constexpr (Epi::AFTER_DRAIN) { E.fused(acc, cur, wr, wc, fr, fq, lds, wid, lane); S.done(cur); }
#undef PG8_SA
#undef PG8_SB
#undef PG8_STAGE
#undef PG8_LDA
#undef PG8_LDB
#undef PG8_MMA
#undef PG8_WAIT_V
#undef PG8_WAIT_L
#undef PG8_BAR
#undef PG8_SCHED
}
}

constexpr int NWAVES = 8;
constexpr int DM = 2048, BATCH = 4, SEQ = 2048, NMETA = 16, LP = SEQ + NMETA, DEPTH = 2, DB = 128, DS = 8, HD = 128;
constexpr int HA = 6, HB = 6, HC = 4, MIX = 2048, NIN = 8984, NP = 8960, NCONV = 2304;
constexpr int MP_ROWS = BATCH * LP, MS_ROWS = DB * DS, MROWS = MP_ROWS + MS_ROWS, MPAD = 9472;
static_assert(MROWS == 9280 && MPAD % 256 == 0 && MPAD >= MROWS && DEPTH == 2, "shapes");
constexpr int C_AQ = 0, C_AK = 768, C_AV = 1536, C_AO = 2304, C_BQ = 3072, C_BK = 3840, C_BV = 4608, C_CQ = 5376, C_CF = 5888, C_CI = 6400, C_Z = 6912;
constexpr size_t O_YP = 0, O_YS = O_YP + (size_t)BATCH * SEQ * DM, O_MCP = O_YS + (size_t)DB * DS * DM, O_MNP = O_MCP + (size_t)DEPTH * BATCH * HA * HD * HD,
    O_MMP = O_MNP + (size_t)DEPTH * BATCH * HA * HD, O_GSP = O_MMP + (size_t)DEPTH * BATCH * HA, O_GCP = O_GSP + (size_t)DEPTH * BATCH * HB * HD * HD,
    O_HSP = O_GCP + (size_t)DEPTH * BATCH * 3 * NCONV, O_MCS = O_HSP + (size_t)DEPTH * BATCH * HC * HD * HD, O_MNS = O_MCS + (size_t)DEPTH * DB * HA * HD * HD,
    O_MMS = O_MNS + (size_t)DEPTH * DB * HA * HD, O_GSS = O_MMS + (size_t)DEPTH * DB * HA, O_GCS = O_GSS + (size_t)DEPTH * DB * HB * HD * HD,
    O_HSS = O_GCS + (size_t)DEPTH * DB * 3 * NCONV, O_END = O_HSS + (size_t)DEPTH * DB * HC * HD * HD;
static_assert(O_END == 90109488, "output size");
constexpr size_t MiB = 1u << 20;
constexpr size_t WS_CTL = 0, CTL_ZERO_BYTES = 1 * MiB;
constexpr size_t WS_WIN = 2 * MiB;
constexpr size_t WS_WOUT = 72 * MiB;
constexpr size_t WS_GW = 88 * MiB;
constexpr size_t WS_GATES = 89 * MiB;
constexpr size_t WS_A = 92 * MiB;
constexpr size_t WS_PROJ = 130 * MiB;
constexpr size_t WS_HCAT = 292 * MiB;
constexpr size_t WS_XRES = 365 * MiB;
constexpr size_t WS_END = 438 * MiB;
static_assert(WS_WIN + (size_t)2 * NP * DM * 2 <= WS_WOUT && WS_A + (size_t)MPAD * DM * 2 <= WS_PROJ && WS_PROJ + (size_t)MPAD * NP * 2 <= WS_HCAT && WS_HCAT + (size_t)MROWS * DM * 4 <= WS_XRES && WS_XRES + (size_t)MROWS * DM * 4 <= WS_END, "ws map");
constexpr int CW_BAR = 4096;
constexpr int RING_BYTES = 131072, LDSCTL_OFF = RING_BYTES, MISC_OFF = LDSCTL_OFF + 320, LDS_BYTES = 147456;

#define GAS __attribute__((address_space(1)))
#define LAS __attribute__((address_space(3)))
typedef unsigned short bf16;
typedef float f32x4 __attribute__((ext_vector_type(4)));
typedef GAS unsigned gu32;
#define RLX_AGENT __ATOMIC_RELAXED, __HIP_MEMORY_SCOPE_AGENT
__device__ __forceinline__ unsigned f2bf(float f) { unsigned u = __builtin_bit_cast(unsigned, f); return (u + 0x7fffu + ((u >> 16) & 1u)) >> 16; }
__device__ __forceinline__ unsigned pk2(float lo, float hi) { return f2bf(lo) | (f2bf(hi) << 16); }
__device__ __forceinline__ float bf2f(unsigned short b) { return __builtin_bit_cast(float, (unsigned)b << 16); }
__device__ __forceinline__ void ld8(const bf16* p, float (&f)[8]) { const uint4 w = *(const uint4*)p;
    f[0] = __builtin_bit_cast(float, w.x << 16); f[1] = __builtin_bit_cast(float, w.x & 0xffff0000u); f[2] = __builtin_bit_cast(float, w.y << 16); f[3] = __builtin_bit_cast(float, w.y & 0xffff0000u);
    f[4] = __builtin_bit_cast(float, w.z << 16); f[5] = __builtin_bit_cast(float, w.z & 0xffff0000u); f[6] = __builtin_bit_cast(float, w.w << 16); f[7] = __builtin_bit_cast(float, w.w & 0xffff0000u); }
__device__ __forceinline__ float sigmoidf_(float x) { return 1.0f / (1.0f + __expf(-x)); }
__device__ __forceinline__ float siluf_(float x) { return x / (1.0f + __expf(-x)); }
__device__ __forceinline__ float logsigmoidf_(float x) { return fminf(x, 0.f) - log1pf(__expf(-fabsf(x))); }
__device__ __forceinline__ float softplusf_(float x) { return fmaxf(x, 0.f) + log1pf(__expf(-fabsf(x))); }
__device__ __forceinline__ float red16(float x) { x += __shfl_xor(x, 1); x += __shfl_xor(x, 2); x += __shfl_xor(x, 4); x += __shfl_xor(x, 8); return x; }
__device__ __forceinline__ float red32(float x) { x = red16(x); x += __shfl_xor(x, 16); return x; }
__device__ __forceinline__ float red64(float x) { x = red32(x); x += __shfl_xor(x, 32); return x; }

#define XB_TMO      128
#define XB_XCNT(j)  (256  + 64 * (j))
#define XB_XSUB(j)  (1280 + 64 * (j))
#define XB_XGEN(j)  (2304 + 64 * (j))
#define XB_TOP      3328
#define XB_TOPGEN   3392
#define XCD_BAR_WORDS 3456
#define XB_SPIN_CAP (1u << 20)
__device__ __forceinline__ unsigned xb_ld(unsigned* p)              { return __hip_atomic_load(p, __ATOMIC_RELAXED, __HIP_MEMORY_SCOPE_AGENT); }
__device__ __forceinline__ unsigned xb_add(unsigned* p, unsigned v) { return __hip_atomic_fetch_add(p, v, __ATOMIC_RELAXED, __HIP_MEMORY_SCOPE_AGENT); }
__device__ __forceinline__ unsigned xb_xcc_id() { return (unsigned)__builtin_amdgcn_s_getreg((3 << 11) | 20) & 0xFu; }
#define XB_SPIN(cond, bar) do { unsigned _sp = 0; while (cond) { __builtin_amdgcn_s_sleep(1); \
    if ((++_sp & 255u) == 0u) { if (xb_ld(&(bar)[XB_TMO])) break; if (_sp > XB_SPIN_CAP) { atomicAdd(&(bar)[XB_TMO], 1u); break; } } } } while (0)
struct XcdBarrier { unsigned* bar; unsigned x; volatile LAS unsigned* st; };
__device__ __forceinline__ XcdBarrier xcd_barrier_post(unsigned* bar, volatile LAS unsigned* st) {
    XcdBarrier b; b.bar = bar; b.x = xb_xcc_id(); b.st = st;
    if (threadIdx.x == 0) (void)xb_add(&bar[XB_XCNT(b.x)], 1u);
    return b;
}
__device__ __forceinline__ void xcd_barrier_complete(unsigned* bar, unsigned x, unsigned& nloc, unsigned& nx) {
    const unsigned G = gridDim.x * gridDim.y * gridDim.z;
    unsigned sum, cnt, mine, sp = 0u;
    for (;;) {
        sum = 0u; cnt = 0u; mine = 0u;
#pragma unroll
        for (unsigned j = 0; j < 16; ++j) { const unsigned c = xb_ld(&bar[XB_XCNT(j)]); sum += c; cnt += (c > 0u) ? 1u : 0u; mine = (j == x) ? c : mine; }
        if (sum == G) break;
        __builtin_amdgcn_s_sleep(1);
        if ((++sp & 255u) == 0u) { if (xb_ld(&bar[XB_TMO])) break; if (sp > XB_SPIN_CAP) { atomicAdd(&bar[XB_TMO], 1u); break; } }
    }
    nloc = mine > 0u ? mine : 1u; nx = cnt > 0u ? cnt : 1u;
}
__device__ __forceinline__ void xcd_barrier(const XcdBarrier& b) {
    asm volatile("s_waitcnt vmcnt(0)" ::: "memory");
    __syncthreads();
    if (threadIdx.x == 0) {
        unsigned* bar = b.bar;
        __builtin_amdgcn_s_waitcnt(0);
        unsigned nloc = b.st[0], nx = b.st[1];
        if (nloc == 0u) { xcd_barrier_complete(bar, b.x, nloc, nx); b.st[0] = nloc; b.st[1] = nx; }
        const unsigned old = xb_add(&bar[XB_XSUB(b.x)], 1u);
        const unsigned gen = old / nloc;
        if (old + 1u == (gen + 1u) * nloc) {
            __builtin_amdgcn_fence(__ATOMIC_RELEASE, "agent");
            asm volatile("s_waitcnt vmcnt(0)" ::: "memory");
            const unsigned og = xb_add(&bar[XB_TOP], 1u);
            const unsigned tg = og / nx;
            if (og + 1u == (tg + 1u) * nx) xb_add(&bar[XB_TOPGEN], 1u);
            else XB_SPIN(xb_ld(&bar[XB_TOPGEN]) == tg, bar);
            __builtin_amdgcn_fence(__ATOMIC_ACQUIRE, "agent");
            xb_add(&bar[XB_XGEN(b.x)], 1u);
            asm volatile("s_waitcnt vmcnt(0)" ::: "memory");
        } else {
            XB_SPIN(xb_ld(&bar[XB_XGEN(b.x)]) == gen, bar);
            __builtin_amdgcn_fence(__ATOMIC_ACQUIRE, "agent");
            asm volatile("s_waitcnt vmcnt(0)" ::: "memory");
        }
    }
    __syncthreads();
}

struct Args { const float* in[19]; float* out; unsigned char* ws; int ph_lo, ph_hi; };
struct Frame {
    LAS unsigned char* lds; const Args* a;
    int tid, lane, wave, G, vb;
};
__device__ __forceinline__ const float* xrow0(const Frame& F, int r) {
    if (r >= MP_ROWS) return F.a->in[1] + (size_t)(r - MP_ROWS) * DM;
    const int b = r / LP, t = r - b * LP;
    return t < NMETA ? F.a->in[8] + (size_t)t * DM : F.a->in[0] + ((size_t)b * SEQ + (t - NMETA)) * DM;
}

__device__ __forceinline__ void p0_convert(const Frame& F) {
    LAS float* T = (LAS float*)F.lds;
    const int tid = F.tid;
    constexpr int TIN = (NP / 64) * (DM / 64), TOUT = (DM / 64) * (MIX / 64), TPL = TIN + TOUT, NT = DEPTH * TPL;
    for (int tl = F.vb; tl < NT; tl += F.G) {
        const int l = tl / TPL; int r = tl - l * TPL;
        const float* src; bf16* dst; int ld_src, n0, k0, sc0;
        if (r < TIN) { const int nt = r >> 5, kt = r & 31; n0 = nt * 64; k0 = kt * 64; sc0 = n0 + (n0 < C_BQ ? 0 : n0 < C_CQ ? 12 : 24); src = F.a->in[10] + (size_t)l * DM * NIN; ld_src = NIN; dst = ((bf16*)(F.a->ws + WS_WIN)) + (size_t)l * NP * DM; }
        else { r -= TIN; const int nt = r >> 5, kt = r & 31; n0 = nt * 64; k0 = kt * 64; sc0 = n0; src = F.a->in[17] + (size_t)l * MIX * DM; ld_src = DM; dst = ((bf16*)(F.a->ws + WS_WOUT)) + (size_t)l * DM * MIX; }
        __syncthreads();
#pragma unroll
        for (int i = 0; i < 8; ++i) { const int k = (tid >> 6) + 8 * i, n = tid & 63; T[k * 65 + n] = src[(size_t)(k0 + k) * ld_src + sc0 + n]; }
        __syncthreads();
        { const int n = tid >> 3, ks = (tid & 7) * 8; float v[8];
#pragma unroll
          for (int j = 0; j < 8; ++j) v[j] = T[(ks + j) * 65 + n];
          uint4 w; w.x = pk2(v[0], v[1]); w.y = pk2(v[2], v[3]); w.z = pk2(v[4], v[5]); w.w = pk2(v[6], v[7]);
          *(uint4*)(dst + (size_t)(n0 + n) * 2048 + k0 + ks) = w; }
    }
    for (int i = F.vb * 512 + tid; i < DEPTH * 24 * DM; i += F.G * 512) {
        const int k = i & (DM - 1), j = (i >> 11) % 24, l = i / (24 * DM);
        const int sc = j < 12 ? 3072 + j : 5388 + (j - 12);
        ((float*)(F.a->ws + WS_GW))[i] = F.a->in[10][((size_t)l * DM + k) * NIN + sc];
    }
}
__device__ __forceinline__ void pa_norm(const Frame& F, int layer) {
    const int lane = F.lane;
    const float* nw = F.a->in[9] + (size_t)layer * DM; const float* gwl = ((float*)(F.a->ws + WS_GW)) + (size_t)layer * 24 * DM;
    for (int r = F.vb * NWAVES + F.wave; r < MROWS; r += F.G * NWAVES) {
        const float* x = layer == 0 ? xrow0(F, r) : ((float*)(F.a->ws + WS_XRES)) + (size_t)r * DM;
        f32x4 v[8]; float ss = 0.f;
#pragma unroll
        for (int i = 0; i < 8; ++i) { v[i] = *(const f32x4*)(x + i * 256 + lane * 4); ss += v[i][0] * v[i][0] + v[i][1] * v[i][1] + v[i][2] * v[i][2] + v[i][3] * v[i][3]; }
        ss = red64(ss);
        const float rs = rsqrtf(ss * (1.0f / DM) + 1e-6f);
#pragma unroll
        for (int i = 0; i < 8; ++i) { const f32x4 w = *(const f32x4*)(nw + i * 256 + lane * 4); v[i] = v[i] * rs * w;
            uint2 o; o.x = pk2(v[i][0], v[i][1]); o.y = pk2(v[i][2], v[i][3]); *(uint2*)(((bf16*)(F.a->ws + WS_A)) + (size_t)r * DM + i * 256 + lane * 4) = o; }
        for (int j = 0; j < 24; ++j) { float s = 0.f; const float* g = gwl + (size_t)j * DM;
#pragma unroll
            for (int i = 0; i < 8; ++i) { const f32x4 w = *(const f32x4*)(g + i * 256 + lane * 4); s += v[i][0] * w[0] + v[i][1] * w[1] + v[i][2] * w[2] + v[i][3] * w[3]; }
            s = red64(s);
            if (lane == 0) ((float*)(F.a->ws + WS_GATES))[(size_t)r * 32 + j] = s; }
    }
}
__device__ __forceinline__ void pd_outnorm(const Frame& F, int layer) {
    const int lane = F.lane;
    const float* ow = F.a->in[16] + (size_t)layer * MIX;
    for (int r = F.vb * NWAVES + F.wave; r < MROWS; r += F.G * NWAVES) {
        const float* hrow = ((float*)(F.a->ws + WS_HCAT)) + (size_t)r * MIX; const bf16* zrow = ((bf16*)(F.a->ws + WS_PROJ)) + (size_t)r * NP + C_Z;
#pragma unroll
        for (int i = 0; i < 8; ++i) { const int c = i * 256 + lane * 4;
            f32x4 hv = *(const f32x4*)(hrow + c); float ss = hv[0] * hv[0] + hv[1] * hv[1] + hv[2] * hv[2] + hv[3] * hv[3];
            ss = red32(ss);
            const float rs = rsqrtf(ss * (1.0f / HD) + 1e-6f);
            const uint2 zz = *(const uint2*)(zrow + c); const f32x4 w = *(const f32x4*)(ow + c);
            const float z0 = __builtin_bit_cast(float, zz.x << 16), z1 = __builtin_bit_cast(float, zz.x & 0xffff0000u), z2 = __builtin_bit_cast(float, zz.y << 16), z3 = __builtin_bit_cast(float, zz.y & 0xffff0000u);
            uint2 o; o.x = pk2(hv[0] * rs * w[0] * siluf_(z0), hv[1] * rs * w[1] * siluf_(z1)); o.y = pk2(hv[2] * rs * w[2] * siluf_(z2), hv[3] * rs * w[3] * siluf_(z3));
            *(uint2*)(((bf16*)(F.a->ws + WS_A)) + (size_t)r * DM + c) = o; }
    }
}
__device__ __forceinline__ void pf_final(const Frame& F) {
    const int lane = F.lane;
    for (int r = F.vb * NWAVES + F.wave; r < MROWS; r += F.G * NWAVES) {
        float* dst;
        if (r >= MP_ROWS) dst = F.a->out + O_YS + (size_t)(r - MP_ROWS) * DM;
        else { const int b = r / LP, t = r - b * LP; if (t < NMETA) continue; dst = F.a->out + O_YP + ((size_t)b * SEQ + (t - NMETA)) * DM; }
        const float* x = ((float*)(F.a->ws + WS_XRES)) + (size_t)r * DM;
        f32x4 v[8]; float ss = 0.f;
#pragma unroll
        for (int i = 0; i < 8; ++i) { v[i] = *(const f32x4*)(x + i * 256 + lane * 4); ss += v[i][0] * v[i][0] + v[i][1] * v[i][1] + v[i][2] * v[i][2] + v[i][3] * v[i][3]; }
        ss = red64(ss);
        const float rs = rsqrtf(ss * (1.0f / DM) + 1e-6f);
#pragma unroll
        for (int i = 0; i < 8; ++i) { const f32x4 w = *(const f32x4*)(F.a->in[18] + i * 256 + lane * 4); *(f32x4*)(dst + i * 256 + lane * 4) = v[i] * rs * w; }
    }
}
constexpr int LQ = 0, LK = 4096, LF = 8192, LV = 12288, LAO = 13312, LSC = 14336;
__device__ __forceinline__ void conv8(const Frame& F, int layer, int sample, int b, size_t row0, int t, int chbase, float (&out)[8]) {
    float acc[8];
#pragma unroll
    for (int i = 0; i < 8; ++i) acc[i] = 0.f;
#pragma unroll
    for (int j = 0; j < 4; ++j) { const int tau = t - 3 + j; float u8[8];
        if (tau >= 0) ld8(((bf16*)(F.a->ws + WS_PROJ)) + (row0 + tau) * NP + C_BQ + chbase, u8);
        else if (sample) { const float* cs = F.a->in[6] + ((size_t)(layer * DB + b) * 3 + (3 + tau)) * NCONV + chbase;
#pragma unroll
            for (int i = 0; i < 8; ++i) u8[i] = cs[i]; }
        else {
#pragma unroll
            for (int i = 0; i < 8; ++i) u8[i] = 0.f; }
        const float* w = F.a->in[14] + ((size_t)layer * 4 + j) * NCONV + chbase;
#pragma unroll
        for (int i = 0; i < 8; ++i) acc[i] += w[i] * u8[i]; }
#pragma unroll
    for (int i = 0; i < 8; ++i) out[i] = siluf_(acc[i]);
}
template <int TY>
__device__ __forceinline__ void scan_item(const Frame& F, int layer, int sample, int b, int h, int eb) {
    LAS float* L_ = (LAS float*)F.lds;
    const int tid = F.tid, el = tid >> 4, dl = tid & 15, e = eb * 32 + el;
    const int L = sample ? DS : LP;
    const size_t row0 = sample ? (size_t)(MP_ROWS + b * DS) : (size_t)b * LP;
    constexpr int NH = TY == 2 ? HC : 6;
    const size_t sidx = (size_t)(layer * (sample ? DB : BATCH) + b) * NH + h;
    const int hcol = (TY == 0 ? 0 : TY == 1 ? 768 : 1536) + h * HD;
    float S[8], nst[8]; float m = 0.f;
#pragma unroll
    for (int j = 0; j < 8; ++j) { S[j] = 0.f; nst[j] = 0.f; }
    if (sample) {
        const float* S0 = (TY == 0 ? F.a->in[2] : TY == 1 ? F.a->in[5] : F.a->in[7]) + sidx * (HD * HD);
#pragma unroll
        for (int j = 0; j < 8; ++j) S[j] = S0[(dl * 8 + j) * HD + e];
        if (TY == 0) {
#pragma unroll
            for (int j = 0; j < 8; ++j) nst[j] = F.a->in[3][sidx * HD + dl * 8 + j];
            m = F.a->in[4][sidx]; }
    }
    for (int t0 = 0; t0 < L; t0 += 32) {
        __syncthreads();
        {
            const int tok = tid >> 4, t = t0 + tok;
            if (t < L) {
                const size_t r = row0 + t; const bf16* pr = ((bf16*)(F.a->ws + WS_PROJ)) + r * NP; const float* gr = ((float*)(F.a->ws + WS_GATES)) + r * 32;
                float q8[8], k8[8], f8[8];
                if (TY == 0) {
                    ld8(pr + C_AQ + h * HD + dl * 8, q8); ld8(pr + C_AK + h * HD + dl * 8, k8);
#pragma unroll
                    for (int j = 0; j < 8; ++j) k8[j] *= 0.08838834764831845f;
                    if (dl < 4) { float v8[8]; ld8(pr + C_AV + h * HD + eb * 32 + dl * 8, v8);
#pragma unroll
                        for (int j = 0; j < 8; ++j) L_[LV + tok * 32 + dl * 8 + j] = v8[j]; }
                    else if (dl < 8) { float a8[8]; ld8(pr + C_AO + h * HD + eb * 32 + (dl - 4) * 8, a8);
#pragma unroll
                        for (int j = 0; j < 8; ++j) L_[LAO + tok * 32 + (dl - 4) * 8 + j] = sigmoidf_(a8[j]); }
                    else if (dl == 8) { L_[LSC + tok * 4 + 0] = gr[h] + F.a->in[11][layer * 12 + h]; L_[LSC + tok * 4 + 1] = logsigmoidf_(gr[6 + h] + F.a->in[11][layer * 12 + 6 + h]); }
                } else if (TY == 1) {
                    conv8(F, layer, sample, b, row0, t, h * HD + dl * 8, q8); conv8(F, layer, sample, b, row0, t, 768 + h * HD + dl * 8, k8);
                    float sq = 0.f, sk = 0.f;
#pragma unroll
                    for (int j = 0; j < 8; ++j) { sq += q8[j] * q8[j]; sk += k8[j] * k8[j]; }
                    sq = red16(sq); sk = red16(sk);
                    const float rq = rsqrtf(sq + 1e-6f) * 0.08838834764831845f, rk = rsqrtf(sk + 1e-6f);
#pragma unroll
                    for (int j = 0; j < 8; ++j) { q8[j] *= rq; k8[j] *= rk; }
                    if (dl < 4) { float v8[8]; conv8(F, layer, sample, b, row0, t, 1536 + h * HD + eb * 32 + dl * 8, v8);
#pragma unroll
                        for (int j = 0; j < 8; ++j) L_[LV + tok * 32 + dl * 8 + j] = v8[j]; }
                    else if (dl == 8) { const float g = -__expf(F.a->in[12][layer * HB + h]) * softplusf_(gr[12 + h] + F.a->in[13][layer * HB + h]);
                        L_[LSC + tok * 4 + 0] = __expf(g); L_[LSC + tok * 4 + 1] = sigmoidf_(gr[18 + h]); }
                } else {
                    float c8[8]; ld8(pr + C_CQ + h * HD + dl * 8, q8); ld8(pr + C_CF + h * HD + dl * 8, c8);
#pragma unroll
                    for (int j = 0; j < 8; ++j) { const int ch = h * HD + dl * 8 + j;
                        const float lb = layer == 0 ? 0.f : 1.0f / (1.0f + __expf(F.a->in[15][ch] - F.a->in[15][512 + ch]));
                        const float sp = 1.0f / (1.0f + __expf(-c8[j])), sn = 1.0f / (1.0f + __expf(c8[j]));
                        f8[j] = lb + (1.0f - lb) * sp; k8[j] = (1.0f - lb) * sn; q8[j] = siluf_(q8[j]); }
                    if (dl < 4) { float v8[8]; ld8(pr + C_CI + h * HD + eb * 32 + dl * 8, v8);
#pragma unroll
                        for (int j = 0; j < 8; ++j) L_[LV + tok * 32 + dl * 8 + j] = v8[j]; }
                }
                float kq = 0.f;
#pragma unroll
                for (int j = 0; j < 8; ++j) kq += q8[j] * k8[j];
                kq = red16(kq);
                if (dl == 0) L_[LSC + tok * 4 + 2] = kq;
#pragma unroll
                for (int j = 0; j < 8; ++j) { L_[LQ + tok * 128 + dl * 8 + j] = TY == 2 ? q8[j] * f8[j] : q8[j]; L_[LK + tok * 128 + dl * 8 + j] = k8[j]; if (TY == 2) L_[LF + tok * 128 + dl * 8 + j] = f8[j]; }
            }
        }
        __syncthreads();
        const int nt = (L - t0) < 32 ? (L - t0) : 32;
        for (int tt = 0; tt < nt; ++tt) {
            float q[8], k[8];
            { const f32x4 a = *(const LAS f32x4*)(L_ + LQ + tt * 128 + dl * 8), c = *(const LAS f32x4*)(L_ + LQ + tt * 128 + dl * 8 + 4);
              q[0] = a[0]; q[1] = a[1]; q[2] = a[2]; q[3] = a[3]; q[4] = c[0]; q[5] = c[1]; q[6] = c[2]; q[7] = c[3]; }
            { const f32x4 a = *(const LAS f32x4*)(L_ + LK + tt * 128 + dl * 8), c = *(const LAS f32x4*)(L_ + LK + tt * 128 + dl * 8 + 4);
              k[0] = a[0]; k[1] = a[1]; k[2] = a[2]; k[3] = a[3]; k[4] = c[0]; k[5] = c[1]; k[6] = c[2]; k[7] = c[3]; }
            const float v = L_[LV + tt * 32 + el], kq = L_[LSC + tt * 4 + 2];
            float* orow = ((float*)(F.a->ws + WS_HCAT)) + (row0 + t0 + tt) * MIX + hcol + e;
            if (TY == 0) {
                const float li = L_[LSC + tt * 4 + 0], lf = L_[LSC + tt * 4 + 1];
                float p = 0.f, nq = 0.f;
#pragma unroll
                for (int j = 0; j < 8; ++j) { p += S[j] * q[j]; nq += nst[j] * q[j]; }
                p = red16(p); nq = red16(nq);
                const float mt = fmaxf(lf + m, li), fp = __expf(lf + m - mt), ip = __expf(li - mt); m = mt;
                const float num = fp * p + ip * kq * v, den = fp * nq + ip * kq;
                const float hh = num / fmaxf(fabsf(den), __expf(fminf(-mt, 60.f)));
                if (dl == 0) *orow = hh * L_[LAO + tt * 32 + el];
#pragma unroll
                for (int j = 0; j < 8; ++j) { const float ik = ip * k[j]; S[j] = fp * S[j] + ik * v; nst[j] = fp * nst[j] + ik; }
            } else if (TY == 1) {
                const float a = L_[LSC + tt * 4 + 0], beta = L_[LSC + tt * 4 + 1];
                float u = 0.f, p = 0.f;
#pragma unroll
                for (int j = 0; j < 8; ++j) { u += S[j] * k[j]; p += S[j] * q[j]; }
                u = red16(u); p = red16(p);
                const float w = v - a * u;
                if (dl == 0) *orow = a * p + beta * kq * w;
                const float bw = beta * w;
#pragma unroll
                for (int j = 0; j < 8; ++j) S[j] = a * S[j] + k[j] * bw;
            } else {
                float f[8];
                { const f32x4 a = *(const LAS f32x4*)(L_ + LF + tt * 128 + dl * 8), c = *(const LAS f32x4*)(L_ + LF + tt * 128 + dl * 8 + 4);
                  f[0] = a[0]; f[1] = a[1]; f[2] = a[2]; f[3] = a[3]; f[4] = c[0]; f[5] = c[1]; f[6] = c[2]; f[7] = c[3]; }
                float p = 0.f;
#pragma unroll
                for (int j = 0; j < 8; ++j) p += S[j] * q[j];
                p = red16(p);
                if (dl == 0) *orow = p + kq * v;
#pragma unroll
                for (int j = 0; j < 8; ++j) S[j] = f[j] * S[j] + k[j] * v;
            }
        }
    }
    {
        float* So = F.a->out + (sample ? (TY == 0 ? O_MCS : TY == 1 ? O_GSS : O_HSS) : (TY == 0 ? O_MCP : TY == 1 ? O_GSP : O_HSP)) + sidx * (HD * HD);
#pragma unroll
        for (int j = 0; j < 8; ++j) So[(dl * 8 + j) * HD + e] = S[j];
        if (TY == 0 && eb == 0) {
            if (el == 0) { float* no = F.a->out + (sample ? O_MNS : O_MNP) + sidx * HD;
#pragma unroll
                for (int j = 0; j < 8; ++j) no[dl * 8 + j] = nst[j]; }
            if (tid == 0) F.a->out[(sample ? O_MMS : O_MMP) + sidx] = m;
        }
    }
}
__device__ __forceinline__ void pc_mixers(const Frame& F, int layer) {
    for (int i = F.vb * 512 + F.tid; i < (BATCH + DB) * 3 * NCONV; i += F.G * 512) {
        const int ch = i % NCONV, j = (i / NCONV) % 3, bb = i / (3 * NCONV);
        if (bb < BATCH) F.a->out[O_GCP + ((size_t)(layer * BATCH + bb) * 3 + j) * NCONV + ch] = bf2f(((bf16*)(F.a->ws + WS_PROJ))[((size_t)bb * LP + (LP - 3) + j) * NP + C_BQ + ch]);
        else { const int b = bb - BATCH; F.a->out[O_GCS + ((size_t)(layer * DB + b) * 3 + j) * NCONV + ch] = bf2f(((bf16*)(F.a->ws + WS_PROJ))[((size_t)MP_ROWS + b * DS + (DS - 3) + j) * NP + C_BQ + ch]); }
    }
    for (int it = F.vb; it < 256; it += F.G) {
        if (it < 96) { const int eb = it & 3, bh = it >> 2; scan_item<0>(F, layer, 0, bh / HA, bh % HA, eb); }
        else if (it < 192) { const int i2 = it - 96, eb = i2 & 3, bh = i2 >> 2; scan_item<1>(F, layer, 0, bh / HB, bh % HB, eb); }
        else { const int i2 = it - 192, eb = i2 & 3, bh = i2 >> 2; scan_item<2>(F, layer, 0, bh / HC, bh % HC, eb); }
    }
    for (int it = F.vb; it < DB * 16 * 4; it += F.G) {
        const int eb = it & 3, bh = it >> 2, b = bh >> 4, hh = bh & 15;
        if (hh < 6) scan_item<0>(F, layer, 1, b, hh, eb);
        else if (hh < 12) scan_item<1>(F, layer, 1, b, hh - 6, eb);
        else scan_item<2>(F, layer, 1, b, hh - 12, eb);
    }
}
constexpr int N_PHASES = 12;
__global__ void __launch_bounds__(NWAVES * 64, 2) hymba_fwd(Args args) {
    extern __shared__ __attribute__((aligned(16))) unsigned char lds[];
    Frame F;
    F.lds = (LAS unsigned char*)lds; F.a = &args;
    F.tid = threadIdx.x; F.lane = F.tid & 63; F.wave = __builtin_amdgcn_readfirstlane(F.tid >> 6);
    F.G = gridDim.x; F.vb = blockIdx.x;
    gu32* ctl = (gu32*)(args.ws + WS_CTL);
    volatile LAS unsigned* MISC = (volatile LAS unsigned*)(F.lds + MISC_OFF);
    for (int u = F.tid; u < (LDS_BYTES - LDSCTL_OFF) / 4; u += NWAVES * 64) ((LAS unsigned*)(F.lds + LDSCTL_OFF))[u] = 0u;
    __syncthreads();
    XcdBarrier bar; bar.bar = (unsigned*)(ctl + CW_BAR); bar.x = 0; bar.st = nullptr;
    const int lo = args.ph_lo, hi = args.ph_hi;
    if (hi - lo > 1) bar = xcd_barrier_post((unsigned*)(ctl + CW_BAR), MISC + 8);
#define IN(k) (lo <= (k) && (k) < hi)
#define SEAM(k) do { if (IN(k) && IN((k) + 1)) xcd_barrier(bar); } while (0)
    if (IN(0)) p0_convert(F);
    SEAM(0);
#define LAYER(layer) do { constexpr int pb = 2 + 5 * (layer); \
        if (IN(pb - 1)) pa_norm(F, (layer)); \
        SEAM(pb - 1); \
        if (IN(pb)) { \
            pg8::Gemm g{((bf16*)(args.ws + WS_A)), ((bf16*)(args.ws + WS_WIN)) + (size_t)(layer) * NP * DM, MPAD, NP, DM}; pg8::StaticOrder S; S.init(MPAD, NP, F.G, (int)blockIdx.x); \
            pg8::EpiBf16 E{((bf16*)(args.ws + WS_PROJ)), NP}; \
            pg8::gemm_phase<pg8::EpiBf16, pg8::StaticOrder, true, true>(F.lds, g, S, E); \
        } \
        SEAM(pb); \
        if (IN(pb + 1)) pc_mixers(F, (layer)); \
        SEAM(pb + 1); \
        if (IN(pb + 2)) pd_outnorm(F, (layer)); \
        SEAM(pb + 2); \
        if (IN(pb + 3)) { \
            pg8::Gemm g{((bf16*)(args.ws + WS_A)), ((bf16*)(args.ws + WS_WOUT)) + (size_t)(layer) * DM * MIX, MPAD, DM, MIX}; pg8::StaticOrder S; S.init(MPAD, DM, F.G, (int)blockIdx.x); \
            pg8::EpiRes E{((float*)(args.ws + WS_XRES)), args.in[0], args.in[8], args.in[1], (layer) == 0 ? 1 : 0, MROWS}; \
            pg8::gemm_phase<pg8::EpiRes, pg8::StaticOrder, true, true>(F.lds, g, S, E); \
        } \
        SEAM(pb + 3); } while (0)
    LAYER(0);
    LAYER(1);
    if (IN(11)) pf_final(F);
}

extern "C" void kernel_launch(void* const* d_in, const int* in_sizes, int n_in, void* d_out, int out_size, void* d_ws, size_t ws_size, hipStream_t stream) {
    static int grid = 0;
    if (grid == 0) {
        if (n_in != 19 || (size_t)out_size != O_END || ws_size < WS_END) { fprintf(stderr, "kernel_launch: unexpected sizes: n_in %d out %d ws %zu (need 19, %zu, >= %zu)\n", n_in, out_size, ws_size, (size_t)O_END, (size_t)WS_END); grid = -1; return; }
        int dev = 0, cus = 0, per_cu = 0;
        if (hipGetDevice(&dev) != hipSuccess || hipDeviceGetAttribute(&cus, hipDeviceAttributeMultiprocessorCount, dev) != hipSuccess) { grid = -1; return; }
        if (hipFuncSetAttribute((const void*)hymba_fwd, hipFuncAttributeMaxDynamicSharedMemorySize, LDS_BYTES) != hipSuccess) { fprintf(stderr, "kernel_launch: hipFuncSetAttribute failed\n"); grid = -1; return; }
        if (hipOccupancyMaxActiveBlocksPerMultiprocessor(&per_cu, (const void*)hymba_fwd, NWAVES * 64, LDS_BYTES) != hipSuccess || per_cu < 1)
            fprintf(stderr, "kernel_launch: note: occupancy query reports %d workgroups per CU\n", per_cu);
        (void)hipGetLastError();
        grid = cus;
    }
    if (grid < 0) return;
    if (hipMemsetAsync((char*)d_ws + WS_CTL, 0, CTL_ZERO_BYTES, stream) != hipSuccess) { fprintf(stderr, "kernel_launch: memset failed\n"); return; }
    Args a{};
    for (int i = 0; i < 19; ++i) a.in[i] = (const float*)d_in[i];
    a.out = (float*)d_out; a.ws = (unsigned char*)d_ws;
#if MK_PER_PHASE
    for (int p = 0; p < N_PHASES; ++p) { a.ph_lo = p; a.ph_hi = p + 1; hipLaunchKernelGGL(hymba_fwd, dim3(grid), dim3(NWAVES * 64), LDS_BYTES, stream, a); }
#else
    a.ph_lo = 0; a.ph_hi = N_PHASES;
    hipLaunchKernelGGL(hymba_fwd, dim3(grid), dim3(NWAVES * 64), LDS_BYTES, stream, a);
#endif
    const hipError_t le = hipPeekAtLastError();
    if (le != hipSuccess) fprintf(stderr, "kernel_launch: launch failed: %s\n", hipGetErrorName(le));
}
```

```cpp
#include <hip/hip_runtime.h>
#include <cstdio>
#include <cstdint>

#ifndef MK_PER_PHASE
#define MK_PER_PHASE 0
#endif

namespace pg8 {
#define PG8_LAS __attribute__((address_space(3)))
typedef unsigned short bf16_t;
typedef short bf16x8 __attribute__((ext_vector_type(8)));
typedef float f32x4 __attribute__((ext_vector_type(4)));
typedef unsigned u32x4 __attribute__((ext_vector_type(4)));
constexpr int BM = 256, BK = 64, HALF = 128, HTB = HALF * BK * 2  , STAGE_BYTES = 8 * HTB, NXCD = 8, WGM = 8;

__host__ __device__ __forceinline__ int lds_byte(int r, int c) { const int st = (r >> 4) * 2 + (c >> 5), rr = r & 15, cc = c & 31, ob = rr * 64 + cc * 2; return st * 1024 + (ob ^ (((ob >> 9) & 1) << 5)); }
__host__ __device__ __forceinline__ void stage_rc(int b, int& R, int& C) { const int st = b / 1024, sb = b % 1024, swz = sb ^ (((sb >> 9) & 1) << 5); R = (st >> 1) * 16 + swz / 64; C = (st & 1) * 32 + (swz % 64) / 2; }
__host__ __device__ __forceinline__ int perm32(int rho) { const int n = rho >> 4, i = rho & 15; return 8 * (i >> 2) + 4 * n + (i & 3); }

struct Unit { int pm, pn; };
struct Gemm { const bf16_t* A; const bf16_t* Bt; int M, N, K; };

struct StaticOrder {
    int nM, nN, nwg, G, c;
    __host__ __device__ void init(int M, int N, int G_, int c_) { nM = M / BM; nN = N / BM; nwg = nM * nN; G = G_; c = c_; }
    __host__ __device__ bool next(int i, Unit& u) const {
        const long L = (long)i * G + c; if (L >= nwg) return false;
        int wgid = (int)L; { const int q = nwg / NXCD, r = nwg % NXCD, xcd = wgid % NXCD, off = wgid / NXCD; wgid = (xcd < r ? xcd * (q + 1) : r * (q + 1) + (xcd - r) * q) + off; }
        const int nig = WGM * nN, gid = wgid / nig, fm = gid * WGM, gsz = (nM - fm) < WGM ? (nM - fm) : WGM;
        u.pm = fm + ((wgid % nig) % gsz); u.pn = (wgid % nig) / gsz; return true;
    }
    __device__ __forceinline__ void a_ready(const Unit&) const {}
    __device__ __forceinline__ void done(const Unit&) const {}
};

struct DefOrder {
    int L0, L1, G, c, nM;
    __device__ __forceinline__ bool next(int i, Unit& u) const { const int L = L0 + i * G + c; if (c < 0 || L >= L1) return false; u.pn = L / nM; u.pm = L - u.pn * nM; return true; }
    __device__ __forceinline__ void a_ready(const Unit&) const {}
    __device__ __forceinline__ void done(const Unit&) const {}
};
typedef __bf16 bf16x2_t __attribute__((ext_vector_type(2)));
typedef float f32x2_t __attribute__((ext_vector_type(2)));
__device__ __forceinline__ unsigned cvt_pk_bf16(float lo, float hi) { const f32x2_t v = {lo, hi}; return __builtin_bit_cast(unsigned, __builtin_convertvector(v, bf16x2_t)); }

struct EpiBf16 {
    static constexpr bool PERM = true, AFTER_DRAIN = false;
    bf16_t* O; int ldc; float* gates; int gate_pn, split, add0, add1;
    __device__ __forceinline__ void operator()(const f32x4 (&acc)[2][2][4][2], const Unit& u, int wr, int wc, int fr, int fq) const {
        const int row0 = u.pm * BM + wr * 64 + fr; const int col0 = (u.pn + (u.pn < split ? add0 : add1)) * BM + wc * 32 + 8 * fq;
        if (u.pn == gate_pn) {
            if (wc == 0 && fq < 3) {
#pragma unroll
                for (int ai = 0; ai < 2; ++ai)
#pragma unroll
                    for (int m = 0; m < 4; ++m) { float* gp = gates + (size_t)(row0 + ai * HALF + m * 16) * 32 + 8 * fq;
                        *(f32x4*)gp = acc[ai][0][m][0]; *(f32x4*)(gp + 4) = acc[ai][0][m][1]; } }
            return; }
#pragma unroll
        for (int ai = 0; ai < 2; ++ai)
#pragma unroll
            for (int m = 0; m < 4; ++m) { bf16_t* rowp = O + (size_t)(row0 + ai * HALF + m * 16) * ldc + col0;
#pragma unroll
                for (int bj = 0; bj < 2; ++bj) { const f32x4 v0 = acc[ai][bj][m][0], v1 = acc[ai][bj][m][1];
                    u32x4 w; w.x = cvt_pk_bf16(v0[0], v0[1]); w.y = cvt_pk_bf16(v0[2], v0[3]); w.z = cvt_pk_bf16(v1[0], v1[1]); w.w = cvt_pk_bf16(v1[2], v1[3]);
                    *(u32x4*)(rowp + bj * HALF) = w; } }
    }
};
struct EpiRes {
    static constexpr bool PERM = false, AFTER_DRAIN = false;
    float* X; const float* xp; const float* meta; const float* xs; int first; int mrows; int wt;
    __device__ __forceinline__ const float* src_row(int r) const {
        if (!first) return X + (size_t)r * 2048;
        if (r >= 8256) return xs + (size_t)(r - 8256) * 2048;
        const int b = r / 2064, t = r - b * 2064;
        return t < 16 ? meta + (size_t)t * 2048 : xp + ((size_t)b * 2048 + (t - 16)) * 2048;
    }
    __device__ __forceinline__ void operator()(const f32x4 (&acc)[2][2][4][2], const Unit& u, int wr, int wc, int fr, int fq) const {
        const int row0 = u.pm * BM + wr * 64 + fr, col0 = u.pn * BM + wc * 32 + 4 * fq;
#pragma unroll
        for (int ai = 0; ai < 2; ++ai)
#pragma unroll
            for (int m = 0; m < 4; ++m) { const int row = row0 + ai * HALF + m * 16;
                if (row < mrows) { const float* sp = src_row(row) + col0; float* dp = X + (size_t)row * 2048 + col0;
#pragma unroll
                    for (int bj = 0; bj < 2; ++bj)
#pragma unroll
                        for (int n = 0; n < 2; ++n) { const f32x4 v = *(const f32x4*)(sp + bj * HALF + n * 16) + acc[ai][bj][m][n]; float* d4 = dp + bj * HALF + n * 16;
                            if (wt) { const float v0 = v[0], v1 = v[1], v2 = v[2], v3 = v[3];
                                __hip_atomic_store((unsigned long long*)d4, (unsigned long long)__builtin_bit_cast(unsigned, v0) | ((unsigned long long)__builtin_bit_cast(unsigned, v1) << 32), __ATOMIC_RELAXED, __HIP_MEMORY_SCOPE_AGENT);
                                __hip_atomic_store((unsigned long long*)(d4 + 2), (unsigned long long)__builtin_bit_cast(unsigned, v2) | ((unsigned long long)__builtin_bit_cast(unsigned, v3) << 32), __ATOMIC_RELAXED, __HIP_MEMORY_SCOPE_AGENT); }
                            else *(f32x4*)d4 = v; } } }
    }
};

template <class Epi, class Sched, bool ALIGN_EPI = false, bool SP2 = false, int AUX_A = 0>
__device__ __forceinline__ void gemm_phase(PG8_LAS unsigned char* lds, const Gemm g, const Sched& S, const Epi& E) {
    int tid_ = threadIdx.x; asm volatile("" : "+v"(tid_));
    const int tid = tid_, wid = __builtin_amdgcn_readfirstlane(tid >> 6), lane = tid & 63, wr = wid >> 2, wc = wid & 3, fr = lane & 15, fq = lane >> 4;
    const int K = g.K, nt = K / BK;
    unsigned voffA[2], voffB[2];
#pragma unroll
    for (int i = 0; i < 2; ++i) { int R, C; stage_rc(tid * 16 + i * 8192, R, C); const int Rb = Epi::PERM ? ((R & ~31) + perm32(R & 31)) : R;
        voffA[i] = (unsigned)(R * K + C) * 2u; voffB[i] = (unsigned)(Rb * K + C) * 2u; }
    const size_t kstep = (size_t)(BK * 2);
    const size_t hstep = (size_t)HALF * K * 2;
    const size_t tstep = 2 * hstep;
    const unsigned ldsw = (unsigned)wid * 1024u;
    const int aoff = lds_byte(wr * 64 + fr, fq * 8), boff = lds_byte(wc * 32 + fr, fq * 8);
#define PG8_SA(b, h) (((b) * 2 + (h)) * HTB)
#define PG8_SB(b, h) ((4 + (b) * 2 + (h)) * HTB)
#define PG8_STAGE_X(bufoff, gbase, voff, AUX) do { _Pragma("unroll") for (int _i = 0; _i < 2; ++_i) \
        __builtin_amdgcn_global_load_lds((const unsigned*)((const char*)(gbase) + (voff)[_i]), (PG8_LAS unsigned*)(lds + (bufoff) + ldsw + _i * 8192), 16, 0, AUX); } while (0)
#define PG8_STAGE(bufoff, gbase, voff) PG8_STAGE_X(bufoff, gbase, voff, 0)
#define PG8_LDA(dst, b, h) do { _Pragma("unroll") for (int m = 0; m < 4; ++m) _Pragma("unroll") for (int k = 0; k < 2; ++k) dst[m][k] = *(const PG8_LAS bf16x8*)(lds + PG8_SA(b, h) + aoff + m * 2048 + k * 1024); } while (0)
#define PG8_LDB(dst, b, h) do { _Pragma("unroll") for (int n = 0; n < 2; ++n) _Pragma("unroll") for (int k = 0; k < 2; ++k) dst[n][k] = *(const PG8_LAS bf16x8*)(lds + PG8_SB(b, h) + boff + n * 2048 + k * 1024); } while (0)
#define PG8_MMA(ai, bj, At, Bt) do { __builtin_amdgcn_s_setprio(1); _Pragma("unroll") for (int m = 0; m < 4; ++m) _Pragma("unroll") for (int n = 0; n < 2; ++n) _Pragma("unroll") for (int k = 0; k < 2; ++k) \
        acc[ai][bj][m][n] = __builtin_amdgcn_mfma_f32_16x16x32_bf16(Bt[n][k], At[m][k], acc[ai][bj][m][n], 0, 0, 0); __builtin_amdgcn_s_setprio(0); } while (0)
#define PG8_WAIT_V(n) asm volatile("s_waitcnt vmcnt(" #n ")" ::: "memory")
#define PG8_WAIT_L(n) asm volatile("s_waitcnt lgkmcnt(" #n ")" ::: "memory")
#define PG8_BAR __builtin_amdgcn_s_barrier()
#define PG8_SCHED __builtin_amdgcn_sched_barrier(0)
    Unit cur, nxt; int ui = 0;
    if (!S.next(0, cur)) return;
    f32x4 acc[2][2][4][2];
#pragma unroll
    for (int a = 0; a < 2; ++a)
#pragma unroll
        for (int b = 0; b < 2; ++b)
#pragma unroll
            for (int m = 0; m < 4; ++m)
#pragma unroll
                for (int n = 0; n < 2; ++n) acc[a][b][m][n] = (f32x4){0.f, 0.f, 0.f, 0.f};
    bf16x8 At[4][2], B0[2][2], B1[2][2];
    const char* cA = (const char*)g.A + (size_t)cur.pm * tstep; const char* cB = (const char*)g.Bt + (size_t)cur.pn * tstep;
    S.a_ready(cur);
    if constexpr (SP2) {
        PG8_STAGE(PG8_SB(0, 0), cB, voffB); PG8_STAGE(PG8_SB(0, 1), cB + hstep, voffB); PG8_STAGE_X(PG8_SA(0, 0), cA, voffA, AUX_A); PG8_STAGE_X(PG8_SA(0, 1), cA + hstep, voffA, AUX_A);
        if (wr == 1) PG8_BAR;
        PG8_WAIT_V(2); PG8_BAR;
        PG8_STAGE(PG8_SB(1, 0), cB + kstep, voffB); PG8_STAGE_X(PG8_SA(1, 0), cA + kstep, voffA, AUX_A); PG8_STAGE(PG8_SB(1, 1), cB + hstep + kstep, voffB);
        PG8_WAIT_V(6); PG8_BAR;
    } else {
        PG8_STAGE(PG8_SB(0, 0), cB, voffB); PG8_STAGE_X(PG8_SA(0, 0), cA, voffA, AUX_A); PG8_STAGE(PG8_SB(0, 1), cB + hstep, voffB); PG8_STAGE_X(PG8_SA(0, 1), cA + hstep, voffA, AUX_A);
        if (wr == 1) PG8_BAR;
        PG8_WAIT_V(4); PG8_BAR;
        PG8_STAGE(PG8_SB(1, 0), cB + kstep, voffB); PG8_STAGE_X(PG8_SA(1, 0), cA + kstep, voffA, AUX_A); PG8_STAGE(PG8_SB(1, 1), cB + hstep + kstep, voffB);
        PG8_WAIT_V(6); PG8_BAR;
    }
    for (;;) {
        const bool has_next = S.next(ui + 1, nxt);
        const char* nA = has_next ? (const char*)g.A + (size_t)nxt.pm * tstep : cA; const char* nB = has_next ? (const char*)g.Bt + (size_t)nxt.pn * tstep : cB;
        for (int t = 0; t < nt; t += 2) {
            const bool last = (t == nt - 2);
            const char* a1 = cA + (size_t)(t + 1) * kstep;
            const char* a2 = last ? nA : cA + (size_t)(t + 2) * kstep; const char* b2 = last ? nB : cB + (size_t)(t + 2) * kstep;
            const char* a3 = a2 + kstep; const char* b3 = b2 + kstep;
            if (last && has_next) S.a_ready(nxt);
            if constexpr (SP2) {
            PG8_LDB(B0, 0, 0); PG8_LDB(B1, 0, 1); PG8_SCHED; PG8_LDA(At, 0, 0); PG8_STAGE_X(PG8_SA(1, 1), a1 + hstep, voffA, AUX_A);
            PG8_WAIT_V(8); PG8_WAIT_L(0); PG8_BAR; PG8_MMA(0, 0, At, B0); PG8_MMA(0, 1, At, B1); PG8_BAR; PG8_SCHED;
            PG8_LDA(At, 0, 1); PG8_STAGE(PG8_SB(0, 0), b2, voffB); PG8_STAGE(PG8_SB(0, 1), b2 + hstep, voffB); PG8_STAGE_X(PG8_SA(0, 0), a2, voffA, AUX_A);
            PG8_WAIT_V(8); PG8_WAIT_L(0); PG8_BAR; PG8_MMA(1, 0, At, B0); PG8_MMA(1, 1, At, B1); PG8_BAR; PG8_SCHED;
            PG8_LDB(B0, 1, 0); PG8_LDB(B1, 1, 1); PG8_SCHED; PG8_LDA(At, 1, 0); PG8_STAGE_X(PG8_SA(0, 1), a2 + hstep, voffA, AUX_A);
            PG8_WAIT_V(8); PG8_WAIT_L(0); PG8_BAR; PG8_MMA(0, 0, At, B0); PG8_MMA(0, 1, At, B1); PG8_BAR; PG8_SCHED;
            PG8_LDA(At, 1, 1); PG8_STAGE(PG8_SB(1, 0), b3, voffB); PG8_STAGE(PG8_SB(1, 1), b3 + hstep, voffB); PG8_STAGE_X(PG8_SA(1, 0), a3, voffA, AUX_A);
            PG8_WAIT_V(8); PG8_WAIT_L(0); PG8_BAR; PG8_MMA(1, 0, At, B0); PG8_MMA(1, 1, At, B1); PG8_BAR; PG8_SCHED;
            } else {
            PG8_LDB(B0, 0, 0); PG8_SCHED; PG8_LDA(At, 0, 0); PG8_STAGE_X(PG8_SA(1, 1), a1 + hstep, voffA, AUX_A);
            PG8_WAIT_L(8); PG8_BAR; PG8_WAIT_L(0); PG8_MMA(0, 0, At, B0); PG8_BAR; PG8_SCHED;
            PG8_LDB(B1, 0, 1); PG8_STAGE(PG8_SB(0, 0), b2, voffB);
            PG8_BAR; PG8_WAIT_L(0); PG8_MMA(0, 1, At, B1); PG8_BAR;
            PG8_LDA(At, 0, 1); PG8_STAGE_X(PG8_SA(0, 0), a2, voffA, AUX_A);
            PG8_BAR; PG8_WAIT_L(0); PG8_MMA(1, 0, At, B0); PG8_BAR; PG8_SCHED;
            PG8_STAGE(PG8_SB(0, 1), b2 + hstep, voffB);
            PG8_WAIT_V(6); PG8_BAR; PG8_MMA(1, 1, At, B1); PG8_BAR;
            PG8_LDB(B0, 1, 0); PG8_SCHED; PG8_LDA(At, 1, 0); PG8_STAGE_X(PG8_SA(0, 1), a2 + hstep, voffA, AUX_A);
            PG8_WAIT_L(8); PG8_BAR; PG8_WAIT_L(0); PG8_MMA(0, 0, At, B0); PG8_BAR; PG8_SCHED;
            PG8_LDB(B1, 1, 1); PG8_STAGE(PG8_SB(1, 0), b3, voffB);
            PG8_BAR; PG8_WAIT_L(0); PG8_MMA(0, 1, At, B1); PG8_BAR;
            PG8_LDA(At, 1, 1); PG8_STAGE_X(PG8_SA(1, 0), a3, voffA, AUX_A);
            PG8_BAR; PG8_WAIT_L(0); PG8_MMA(1, 0, At, B0); PG8_BAR; PG8_SCHED;
            PG8_STAGE(PG8_SB(1, 1), b3 + hstep, voffB);
            PG8_WAIT_V(6); PG8_BAR; PG8_MMA(1, 1, At, B1); PG8_BAR;
            }
        }
        if constexpr (ALIGN_EPI) { if (wr == 0) PG8_BAR; }
        if constexpr (!Epi::AFTER_DRAIN) { E(acc, cur, wr, wc, fr, fq); S.done(cur); }
        if (!has_next) break;
#pragma unroll
        for (int a = 0; a < 2; ++a)
#pragma unroll
            for (int b = 0; b < 2; ++b)
#pragma unroll
                for (int m = 0; m < 4; ++m)
#pragma unroll
                    for (int n = 0; n < 2; ++n) acc[a][b][m][n] = (f32x4){0.f, 0.f, 0.f, 0.f};
        cur = nxt; cA = nA; cB = nB; ++ui;
        if constexpr (ALIGN_EPI) { if (wr == 1) PG8_BAR; }
    }
    PG8_WAIT_V(0);
    if constexpr (!ALIGN_EPI) { if (wr == 0) PG8_BAR; }
    PG8_BAR;
    if constexpr (Epi::AFTER_DRAIN) { E.fused(acc, cur, wr, wc, fr, fq, lds, wid, lane); S.done(cur); }
#undef PG8_SA
#undef PG8_SB
#undef PG8_STAGE
#undef PG8_STAGE_X
#undef PG8_LDA
#undef PG8_LDB
#undef PG8_MMA
#undef PG8_WAIT_V
#undef PG8_WAIT_L
#undef PG8_BAR
#undef PG8_SCHED
}
}

constexpr int NWAVES = 8;
constexpr int DM = 2048, BATCH = 4, SEQ = 2048, NMETA = 16, LP = SEQ + NMETA, DEPTH = 2, DB = 128, DS = 8, HD = 128;
constexpr int HA = 6, HB = 6, HC = 4, MIX = 2048, NIN = 8984, NP = 8960, NPG = 9216, NMAIN = 6400, NDEF = NPG - NMAIN, NCONV = 2304;
constexpr int MP_ROWS = BATCH * LP, MS_ROWS = DB * DS, MROWS = MP_ROWS + MS_ROWS, MPAD = 9472;
static_assert(MROWS == 9280 && MPAD % 256 == 0 && MPAD >= MROWS && DEPTH == 2, "shapes");
constexpr int C_AQ = 0, C_AK = 768, C_AV = 1536, C_AO = 2304, C_BQ = 3072, C_BK = 3840, C_BV = 4608, C_CQ = 5376, C_CF = 5888, C_CI = 6400, C_Z = 6912;
constexpr size_t O_YP = 0, O_YS = O_YP + (size_t)BATCH * SEQ * DM, O_MCP = O_YS + (size_t)DB * DS * DM, O_MNP = O_MCP + (size_t)DEPTH * BATCH * HA * HD * HD,
    O_MMP = O_MNP + (size_t)DEPTH * BATCH * HA * HD, O_GSP = O_MMP + (size_t)DEPTH * BATCH * HA, O_GCP = O_GSP + (size_t)DEPTH * BATCH * HB * HD * HD,
    O_HSP = O_GCP + (size_t)DEPTH * BATCH * 3 * NCONV, O_MCS = O_HSP + (size_t)DEPTH * BATCH * HC * HD * HD, O_MNS = O_MCS + (size_t)DEPTH * DB * HA * HD * HD,
    O_MMS = O_MNS + (size_t)DEPTH * DB * HA * HD, O_GSS = O_MMS + (size_t)DEPTH * DB * HA, O_GCS = O_GSS + (size_t)DEPTH * DB * HB * HD * HD,
    O_HSS = O_GCS + (size_t)DEPTH * DB * 3 * NCONV, O_END = O_HSS + (size_t)DEPTH * DB * HC * HD * HD;
static_assert(O_END == 90109488, "output size");
constexpr size_t MiB = 1u << 20;
constexpr size_t WS_CTL = 0, CTL_ZERO_BYTES = 96 * 1024;
constexpr size_t WS_WIN = 2 * MiB;
constexpr size_t WS_WOUT = 74 * MiB;
constexpr size_t WS_GATES = 90 * MiB;
constexpr size_t WS_A = 92 * MiB;
constexpr size_t WS_PROJ = 130 * MiB;
constexpr size_t WS_HCAT = 292 * MiB;
constexpr size_t WS_XRES = 330 * MiB;
constexpr size_t WS_BLOB_C = 403 * MiB;
constexpr size_t WS_BLOB_B = 429 * MiB;
constexpr size_t WS_END = 498 * MiB;
static_assert(WS_WIN + (size_t)2 * NPG * DM * 2 <= WS_WOUT && WS_WOUT + (size_t)2 * DM * MIX * 2 <= WS_GATES && WS_GATES + (size_t)MPAD * 32 * 4 <= WS_A && WS_A + (size_t)MPAD * DM * 2 <= WS_PROJ && WS_PROJ + (size_t)MPAD * NP * 2 <= WS_HCAT && WS_HCAT + (size_t)MROWS * DM * 2 <= WS_XRES && WS_XRES + (size_t)MROWS * DM * 4 <= WS_BLOB_C, "ws map");
constexpr int CW_BAR = 4096;
constexpr int RING_BYTES = 131072, LDSCTL_OFF = RING_BYTES, MISC_OFF = LDSCTL_OFF + 320, LDS_BYTES = 147456;

#define GAS __attribute__((address_space(1)))
#define LAS __attribute__((address_space(3)))
typedef unsigned short bf16;
typedef float f32x4 __attribute__((ext_vector_type(4)));
typedef GAS unsigned gu32;
#define RLX_AGENT __ATOMIC_RELAXED, __HIP_MEMORY_SCOPE_AGENT
__device__ __forceinline__ unsigned f2bf(float f) { unsigned u = __builtin_bit_cast(unsigned, f); return (u + 0x7fffu + ((u >> 16) & 1u)) >> 16; }
typedef __bf16 bf16x2_t __attribute__((ext_vector_type(2)));
typedef float f32x2_t __attribute__((ext_vector_type(2)));
__device__ __forceinline__ unsigned pk2(float lo, float hi) { const f32x2_t v = {lo, hi}; return __builtin_bit_cast(unsigned, __builtin_convertvector(v, bf16x2_t)); }
__device__ __forceinline__ float bf2f(unsigned short b) { return __builtin_bit_cast(float, (unsigned)b << 16); }
__device__ __forceinline__ void ld8(const bf16* p, float (&f)[8]) { const uint4 w = *(const uint4*)p;
    f[0] = __builtin_bit_cast(float, w.x << 16); f[1] = __builtin_bit_cast(float, w.x & 0xffff0000u); f[2] = __builtin_bit_cast(float, w.y << 16); f[3] = __builtin_bit_cast(float, w.y & 0xffff0000u);
    f[4] = __builtin_bit_cast(float, w.z << 16); f[5] = __builtin_bit_cast(float, w.z & 0xffff0000u); f[6] = __builtin_bit_cast(float, w.w << 16); f[7] = __builtin_bit_cast(float, w.w & 0xffff0000u); }
__device__ __forceinline__ float sigmoidf_(float x) { return __builtin_amdgcn_rcpf(1.0f + __expf(-x)); }
__device__ __forceinline__ float siluf_(float x) { return x * __builtin_amdgcn_rcpf(1.0f + __expf(-x)); }
__device__ __forceinline__ float logsigmoidf_(float x) { return fminf(x, 0.f) - log1pf(__expf(-fabsf(x))); }
__device__ __forceinline__ float softplusf_(float x) { return fmaxf(x, 0.f) + log1pf(__expf(-fabsf(x))); }
__device__ __forceinline__ float red16(float x) {
    x += __builtin_bit_cast(float, __builtin_amdgcn_update_dpp(0, __builtin_bit_cast(int, x), 0xB1, 0xF, 0xF, true));
    x += __builtin_bit_cast(float, __builtin_amdgcn_update_dpp(0, __builtin_bit_cast(int, x), 0x4E, 0xF, 0xF, true));
    x += __builtin_bit_cast(float, __builtin_amdgcn_update_dpp(0, __builtin_bit_cast(int, x), 0x141, 0xF, 0xF, true));
    x += __builtin_bit_cast(float, __builtin_amdgcn_update_dpp(0, __builtin_bit_cast(int, x), 0x140, 0xF, 0xF, true));
    return x; }
__device__ __forceinline__ float red32(float x) { x = red16(x); x += __shfl_xor(x, 16); return x; }
__device__ __forceinline__ float red64(float x) { x = red32(x); x += __shfl_xor(x, 32); return x; }

#define XB_TMO      128
#define XB_XCNT(j)  (256  + 64 * (j))
#define XB_XSUB(j)  (1280 + 64 * (j))
#define XB_XGEN(j)  (2304 + 64 * (j))
#define XB_TOP      3328
#define XB_TOPGEN   3392
#define XCD_BAR_WORDS 3456
#define XB_SPIN_CAP (1u << 20)
__device__ __forceinline__ unsigned xb_ld(unsigned* p)              { return __hip_atomic_load(p, __ATOMIC_RELAXED, __HIP_MEMORY_SCOPE_AGENT); }
__device__ __forceinline__ unsigned xb_add(unsigned* p, unsigned v) { return __hip_atomic_fetch_add(p, v, __ATOMIC_RELAXED, __HIP_MEMORY_SCOPE_AGENT); }
__device__ __forceinline__ unsigned xb_xcc_id() { return (unsigned)__builtin_amdgcn_s_getreg((3 << 11) | 20) & 0xFu; }
#define XB_SPIN(cond, bar) do { unsigned _sp = 0; while (cond) { __builtin_amdgcn_s_sleep(1); \
    if ((++_sp & 255u) == 0u) { if (xb_ld(&(bar)[XB_TMO])) break; if (_sp > XB_SPIN_CAP) { atomicAdd(&(bar)[XB_TMO], 1u); break; } } } } while (0)
struct XcdBarrier { unsigned* bar; unsigned x; volatile LAS unsigned* st; };
__device__ __forceinline__ XcdBarrier xcd_barrier_post(unsigned* bar, volatile LAS unsigned* st) {
    XcdBarrier b; b.bar = bar; b.x = xb_xcc_id(); b.st = st;
    if (threadIdx.x == 0) (void)xb_add(&bar[XB_XCNT(b.x)], 1u);
    return b;
}
__device__ __forceinline__ void xcd_barrier_complete(unsigned* bar, unsigned x, unsigned& nloc, unsigned& nx) {
    const unsigned G = gridDim.x * gridDim.y * gridDim.z;
    unsigned sum, cnt, mine, sp = 0u;
    for (;;) {
        sum = 0u; cnt = 0u; mine = 0u;
#pragma unroll
        for (unsigned j = 0; j < 16; ++j) { const unsigned c = xb_ld(&bar[XB_XCNT(j)]); sum += c; cnt += (c > 0u) ? 1u : 0u; mine = (j == x) ? c : mine; }
        if (sum == G) break;
        __builtin_amdgcn_s_sleep(1);
        if ((++sp & 255u) == 0u) { if (xb_ld(&bar[XB_TMO])) break; if (sp > XB_SPIN_CAP) { atomicAdd(&bar[XB_TMO], 1u); break; } }
    }
    nloc = mine > 0u ? mine : 1u; nx = cnt > 0u ? cnt : 1u;
}
__device__ __forceinline__ void xcd_barrier(const XcdBarrier& b) {
    asm volatile("s_waitcnt vmcnt(0)" ::: "memory");
    __syncthreads();
    if (threadIdx.x == 0) {
        unsigned* bar = b.bar;
        __builtin_amdgcn_s_waitcnt(0);
        unsigned nloc = b.st[0], nx = b.st[1];
        if (nloc == 0u) { xcd_barrier_complete(bar, b.x, nloc, nx); b.st[0] = nloc; b.st[1] = nx; }
        const unsigned old = xb_add(&bar[XB_XSUB(b.x)], 1u);
        const unsigned gen = old / nloc;
        if (old + 1u == (gen + 1u) * nloc) {
            __builtin_amdgcn_fence(__ATOMIC_RELEASE, "agent");
            asm volatile("s_waitcnt vmcnt(0)" ::: "memory");
            const unsigned og = xb_add(&bar[XB_TOP], 1u);
            const unsigned tg = og / nx;
            if (og + 1u == (tg + 1u) * nx) xb_add(&bar[XB_TOPGEN], 1u);
            else XB_SPIN(xb_ld(&bar[XB_TOPGEN]) == tg, bar);
            __builtin_amdgcn_fence(__ATOMIC_ACQUIRE, "agent");
            xb_add(&bar[XB_XGEN(b.x)], 1u);
            asm volatile("s_waitcnt vmcnt(0)" ::: "memory");
        } else {
            XB_SPIN(xb_ld(&bar[XB_XGEN(b.x)]) == gen, bar);
            __builtin_amdgcn_fence(__ATOMIC_ACQUIRE, "agent");
            asm volatile("s_waitcnt vmcnt(0)" ::: "memory");
        }
    }
    __syncthreads();
}

struct Args { const float* in[19]; float* out; unsigned char* ws; int ph_lo, ph_hi; };
struct Frame {
    LAS unsigned char* lds; const Args* a;
    int tid, lane, wave, G, vb;
};
__device__ __forceinline__ const float* xrow0(const Frame& F, int r) {
    if (r >= MP_ROWS) return F.a->in[1] + (size_t)(r - MP_ROWS) * DM;
    const int b = r / LP, t = r - b * LP;
    return t < NMETA ? F.a->in[8] + (size_t)t * DM : F.a->in[0] + ((size_t)b * SEQ + (t - NMETA)) * DM;
}

__device__ __forceinline__ void p0_convert(const Frame& F, const int wl, const int vb0, const int nb, const int t_lo, const int t_hi) {
    LAS float* T = (LAS float*)F.lds;
    int tid_ = ((int)threadIdx.x); asm volatile("" : "+v"(tid_)); const int tid = tid_;
    constexpr int TIN = (NP / 64) * (DM / 64), TOUT = (DM / 64) * (MIX / 64), TPL = TIN + TOUT, NT = TPL;
#define P0_TILE(tl_, src_, dst_, ld_, n0_, k0_, sc0_) do { const int l_ = wl; int r_ = (tl_); \
        if (r_ < TIN) { const int nt_ = r_ >> 5, kt_ = r_ & 31; n0_ = nt_ * 64; k0_ = kt_ * 64; sc0_ = n0_ + (n0_ < C_BQ ? 0 : n0_ < C_CQ ? 12 : 24); { const int t_ = n0_ >> 8; n0_ = ((t_ < 9 ? t_ : t_ < 12 ? t_ + 16 : t_ < 27 ? t_ - 3 : t_ + 1) << 8) | (n0_ & 255); } src_ = F.a->in[10] + (size_t)l_ * DM * NIN; ld_ = NIN; dst_ = ((bf16*)(F.a->ws + WS_WIN)) + (size_t)l_ * NPG * DM; } \
        else { r_ -= TIN; const int nt_ = r_ >> 5, kt_ = r_ & 31; n0_ = nt_ * 64; k0_ = kt_ * 64; sc0_ = n0_; src_ = F.a->in[17] + (size_t)l_ * MIX * DM; ld_ = DM; dst_ = ((bf16*)(F.a->ws + WS_WOUT)) + (size_t)l_ * DM * MIX; } } while (0)
    LAS float* T1 = T + 64 * 65;
    float pv[8], pw[8];
#define P0_LOAD(tl_, dstv_) do { if ((tl_) < t_hi) { const float* src_l; bf16* dst_l; int ld_l, n0_l, k0_l, sc0_l; P0_TILE((tl_), src_l, dst_l, ld_l, n0_l, k0_l, sc0_l); (void)dst_l; (void)n0_l; \
        _Pragma("unroll") for (int i = 0; i < 8; ++i) dstv_[i] = src_l[(size_t)(k0_l + (tid >> 6) + 8 * i) * ld_l + sc0_l + (tid & 63)]; } } while (0)
#define P0_STORE(tl_, Tb_) do { if ((tl_) < t_hi) { const float* src_s; bf16* dst_s; int ld_s, n0_s, k0_s, sc0_s; P0_TILE((tl_), src_s, dst_s, ld_s, n0_s, k0_s, sc0_s); (void)src_s; (void)ld_s; (void)sc0_s; \
        const int n = tid >> 3, ks = (tid & 7) * 8; float v[8]; \
        _Pragma("unroll") for (int j = 0; j < 8; ++j) v[j] = Tb_[(ks + j) * 65 + n]; \
        uint4 w; w.x = pk2(v[0], v[1]); w.y = pk2(v[2], v[3]); w.z = pk2(v[4], v[5]); w.w = pk2(v[6], v[7]); \
        *(uint4*)(dst_s + (size_t)(n0_s + n) * 2048 + k0_s + ks) = w; } } while (0)
    P0_LOAD(t_lo + vb0, pv); P0_LOAD(t_lo + vb0 + nb, pw);
    for (int tl = t_lo + vb0; tl < t_hi; tl += 2 * nb) {
        __syncthreads();
#pragma unroll
        for (int i = 0; i < 8; ++i) T[((tid >> 6) + 8 * i) * 65 + (tid & 63)] = pv[i];
        if (tl + nb < t_hi) {
#pragma unroll
            for (int i = 0; i < 8; ++i) T1[((tid >> 6) + 8 * i) * 65 + (tid & 63)] = pw[i]; }
        __syncthreads();
        P0_LOAD(tl + 2 * nb, pv); P0_LOAD(tl + 3 * nb, pw);
        P0_STORE(tl, T); P0_STORE(tl + nb, T1);
    }
#undef P0_LOAD
#undef P0_STORE
#undef P0_TILE
    if (t_lo == 0) for (int i = vb0 * 512 + tid; i < 24 * DM; i += nb * 512) {
        const int k = i & (DM - 1), j = i >> 11, l = wl;
        const int sc = j < 12 ? 3072 + j : 5388 + (j - 12);
        ((bf16*)(F.a->ws + WS_WIN))[((size_t)l * NPG + 6144 + j) * DM + k] = (bf16)f2bf(F.a->in[10][((size_t)l * DM + k) * NIN + sc]);
    }
}
__device__ __forceinline__ void pa_norm(const Frame& F, int layer) {
    const int lane = ((int)threadIdx.x & 63);
    const float* nw = F.a->in[9] + (size_t)layer * DM;
    for (int r = F.vb * NWAVES + F.wave; r < MROWS; r += F.G * NWAVES) {
        const float* x = layer == 0 ? xrow0(F, r) : ((float*)(F.a->ws + WS_XRES)) + (size_t)r * DM;
        f32x4 v[8]; float ss = 0.f;
#pragma unroll
        for (int i = 0; i < 8; ++i) { v[i] = *(const f32x4*)(x + i * 256 + lane * 4); ss += v[i][0] * v[i][0] + v[i][1] * v[i][1] + v[i][2] * v[i][2] + v[i][3] * v[i][3]; }
        ss = red64(ss);
        const float rs = rsqrtf(ss * (1.0f / DM) + 1e-6f);
#pragma unroll
        for (int i = 0; i < 8; ++i) { const f32x4 w = *(const f32x4*)(nw + i * 256 + lane * 4); v[i] = v[i] * rs * w;
            uint2 o; o.x = pk2(v[i][0], v[i][1]); o.y = pk2(v[i][2], v[i][3]); *(uint2*)(((bf16*)(F.a->ws + WS_A)) + (size_t)r * DM + i * 256 + lane * 4) = o; }
    }
}
__device__ __forceinline__ void pd_row2(const Frame& F, int layer, int r0) {
    int lane_ = ((int)threadIdx.x & 63); asm volatile("" : "+v"(lane_)); const int lane = lane_;
    const float* ow = F.a->in[16] + (size_t)layer * MIX;
    const bf16* hrow = ((const bf16*)(F.a->ws + WS_HCAT)) + (size_t)r0 * MIX; const bf16* zrow = ((bf16*)(F.a->ws + WS_PROJ)) + (size_t)r0 * NP + C_Z;
    const float* gt = ((const float*)(F.a->ws + WS_GATES)) + (size_t)r0 * 32 + 24;
    uint2 hw[2][8], zz[2][8], aw[2][3]; float rd[2][3]; f32x4 w[8];
#pragma unroll
    for (int q = 0; q < 2; ++q) {
#pragma unroll
        for (int i = 0; i < 8; ++i) { const int c = i * 256 + lane * 4; hw[q][i] = *(const uint2*)(hrow + (size_t)q * MIX + c); zz[q][i] = *(const uint2*)(zrow + (size_t)q * NP + c); }
#pragma unroll
        for (int i = 0; i < 3; ++i) { const int c = i * 256 + lane * 4; aw[q][i] = *(const uint2*)(zrow + (size_t)q * NP - C_Z + C_AO + c); rd[q][i] = gt[q * 32 + (c >> 7)]; } }
#pragma unroll
    for (int i = 0; i < 8; ++i) w[i] = *(const f32x4*)(ow + i * 256 + lane * 4);
    asm volatile("" ::: "memory");
#pragma unroll
    for (int i = 0; i < 8; ++i) { const int c = i * 256 + lane * 4;
#pragma unroll
        for (int q = 0; q < 2; ++q) {
            f32x4 hv = (f32x4){__builtin_bit_cast(float, hw[q][i].x << 16), __builtin_bit_cast(float, hw[q][i].x & 0xffff0000u), __builtin_bit_cast(float, hw[q][i].y << 16), __builtin_bit_cast(float, hw[q][i].y & 0xffff0000u)};
            if (i < 3) { const float rdi = __builtin_amdgcn_rcpf(rd[q][i < 3 ? i : 0]);
                const uint2 a = aw[q][i < 3 ? i : 0];
                hv[0] *= rdi * sigmoidf_(__builtin_bit_cast(float, a.x << 16)); hv[1] *= rdi * sigmoidf_(__builtin_bit_cast(float, a.x & 0xffff0000u)); hv[2] *= rdi * sigmoidf_(__builtin_bit_cast(float, a.y << 16)); hv[3] *= rdi * sigmoidf_(__builtin_bit_cast(float, a.y & 0xffff0000u)); }
            float ss = hv[0] * hv[0] + hv[1] * hv[1] + hv[2] * hv[2] + hv[3] * hv[3];
            ss = red32(ss);
            const float rs = rsqrtf(ss * (1.0f / HD) + 1e-6f);
            const uint2 z = zz[q][i];
            const float z0 = __builtin_bit_cast(float, z.x << 16), z1 = __builtin_bit_cast(float, z.x & 0xffff0000u), z2 = __builtin_bit_cast(float, z.y << 16), z3 = __builtin_bit_cast(float, z.y & 0xffff0000u);
            uint2 o; o.x = pk2(hv[0] * rs * w[i][0] * siluf_(z0), hv[1] * rs * w[i][1] * siluf_(z1)); o.y = pk2(hv[2] * rs * w[i][2] * siluf_(z2), hv[3] * rs * w[i][3] * siluf_(z3));
            __hip_atomic_store((unsigned long long*)(((bf16*)(F.a->ws + WS_A)) + (size_t)(r0 + q) * DM + c), (unsigned long long)o.x | ((unsigned long long)o.y << 32), __ATOMIC_RELAXED, __HIP_MEMORY_SCOPE_AGENT); }
    }
}
__device__ __forceinline__ void xnorm_row2(const Frame& F, int layer, int r0) {
    int lane_ = ((int)threadIdx.x & 63); asm volatile("" : "+v"(lane_)); const int lane = lane_;
    const float* nw = layer == 0 ? F.a->in[9] + (size_t)DM : F.a->in[18];
#pragma unroll
    for (int q = 0; q < 2; ++q) { const int r = r0 + q;
        float* dst = nullptr;
        if (layer != 0) { if (r >= MP_ROWS) dst = F.a->out + O_YS + (size_t)(r - MP_ROWS) * DM; else { const int b = r / LP, t = r - b * LP; if (t < NMETA) continue; dst = F.a->out + O_YP + ((size_t)b * SEQ + (t - NMETA)) * DM; } }
        const float* x = ((const float*)(F.a->ws + WS_XRES)) + (size_t)r * DM;
        f32x4 v[8]; float ss = 0.f;
#pragma unroll
        for (int i = 0; i < 8; ++i) { const unsigned long long a = __hip_atomic_load((const unsigned long long*)(x + i * 256 + lane * 4), __ATOMIC_RELAXED, __HIP_MEMORY_SCOPE_AGENT), b2 = __hip_atomic_load((const unsigned long long*)(x + i * 256 + lane * 4 + 2), __ATOMIC_RELAXED, __HIP_MEMORY_SCOPE_AGENT);
            v[i] = (f32x4){__builtin_bit_cast(float, (unsigned)a), __builtin_bit_cast(float, (unsigned)(a >> 32)), __builtin_bit_cast(float, (unsigned)b2), __builtin_bit_cast(float, (unsigned)(b2 >> 32))};
            ss += v[i][0] * v[i][0] + v[i][1] * v[i][1] + v[i][2] * v[i][2] + v[i][3] * v[i][3]; }
        ss = red64(ss);
        const float rs = rsqrtf(ss * (1.0f / DM) + 1e-6f);
#pragma unroll
        for (int i = 0; i < 8; ++i) { const f32x4 w = *(const f32x4*)(nw + i * 256 + lane * 4); const f32x4 y = v[i] * rs * w;
            if (layer == 0) { uint2 o; o.x = pk2(y[0], y[1]); o.y = pk2(y[2], y[3]); *(uint2*)(((bf16*)(F.a->ws + WS_A)) + (size_t)r * DM + i * 256 + lane * 4) = o; }
            else *(f32x4*)(dst + i * 256 + lane * 4) = y; }
    }
}
constexpr int PDG_PARTS = 16, PDG_NPAN = MPAD / 256, PDG_CTL = 16384, PDG_CTL_LAYER = 2048;
__device__ __forceinline__ void pdg_phase(const Frame& F, int layer) {
    gu32* qb = (gu32*)(F.a->ws + WS_CTL) + PDG_CTL + layer * PDG_CTL_LAYER;
    volatile LAS int* slot = (volatile LAS int*)(F.lds + LDSCTL_OFF + 16);
    const pg8::Gemm g{((bf16*)(F.a->ws + WS_A)), ((bf16*)(F.a->ws + WS_WOUT)) + (size_t)layer * DM * MIX, MPAD, DM, MIX};
    const pg8::EpiRes E{((float*)(F.a->ws + WS_XRES)), F.a->in[0], F.a->in[8], F.a->in[1], layer == 0 ? 1 : 0, MROWS, 0};
    constexpr int conv_tiles = 16, n_conv = (4480 + 1024) / conv_tiles;
    int xq = F.vb & 7, tried = 0;
    for (;;) {
        const int np = (PDG_NPAN - xq + 7) >> 3, total = 2 * PDG_PARTS + (np - 2) * (PDG_PARTS + 8) + 16;
        __syncthreads(); if (((int)threadIdx.x) == 0) *slot = (int)__hip_atomic_fetch_add(qb + 16 * xq, 1u, __ATOMIC_RELAXED, __HIP_MEMORY_SCOPE_AGENT); __syncthreads();
        const int i = __builtin_amdgcn_readfirstlane(*slot);
        if (i >= total) { if (++tried >= 8) break; xq = (xq + 1) & 7; continue; }
        int pd_k = -1, pd_part = 0, gm_k = -1, gm_n = 0;
        if (i < 2 * PDG_PARTS) { pd_k = i / PDG_PARTS; pd_part = i % PDG_PARTS; }
        else { const int j = i - 2 * PDG_PARTS, q = j / (PDG_PARTS + 8), r = j - q * (PDG_PARTS + 8);
            if (q < np - 2) { if (r < PDG_PARTS) { pd_k = 2 + q; pd_part = r; } else { gm_k = q; gm_n = r - PDG_PARTS; } }
            else { const int k = j - (np - 2) * (PDG_PARTS + 8); gm_k = np - 2 + (k >> 3); gm_n = k & 7; } }
        if (pd_k >= 0) {
            const int panel = xq + 8 * pd_k, r0 = panel * 256 + pd_part * 16 + F.wave * 2;
            if (r0 < MROWS) pd_row2(F, layer, r0);
            asm volatile("s_waitcnt vmcnt(0)" ::: "memory");
            __syncthreads();
            if (((int)threadIdx.x) == 0) (void)__hip_atomic_fetch_add(qb + 256 + 16 * panel, 1u, __ATOMIC_RELAXED, __HIP_MEMORY_SCOPE_AGENT);
        } else {
            const int panel = xq + 8 * gm_k;
            if (((int)threadIdx.x) == 0) { unsigned sp = 0;
                while (__hip_atomic_load(qb + 256 + 16 * panel, __ATOMIC_RELAXED, __HIP_MEMORY_SCOPE_AGENT) < (unsigned)PDG_PARTS) { __builtin_amdgcn_s_sleep(2); if (++sp > (1u << 22)) break; }
            }
            __syncthreads();
            const int L = gm_n * PDG_NPAN + panel;
            const pg8::DefOrder D{L, L + 1, 1, 0, PDG_NPAN};
            pg8::gemm_phase<pg8::EpiRes, pg8::DefOrder, true, true, 0>(F.lds, g, D, E);
            if (((int)threadIdx.x) == 0) { __builtin_amdgcn_fence(__ATOMIC_RELEASE, "agent"); asm volatile("s_waitcnt vmcnt(0)" ::: "memory");
                (void)__hip_atomic_fetch_add(qb + 1024 + 16 * panel, 1u, __ATOMIC_RELAXED, __HIP_MEMORY_SCOPE_AGENT); }
        }
    }
    if (layer == 0) for (;;) {
        __syncthreads(); if (((int)threadIdx.x) == 0) *slot = (int)__hip_atomic_fetch_add(qb + 128, 1u, __ATOMIC_RELAXED, __HIP_MEMORY_SCOPE_AGENT); __syncthreads();
        const int t = __builtin_amdgcn_readfirstlane(*slot);
        if (t >= n_conv) break;
        p0_convert(F, 1, 0, 1, t * conv_tiles, (t + 1) * conv_tiles);
    }
    for (;;) {
        __syncthreads(); if (((int)threadIdx.x) == 0) *slot = (int)__hip_atomic_fetch_add(qb + 144, 1u, __ATOMIC_RELAXED, __HIP_MEMORY_SCOPE_AGENT); __syncthreads();
        const int t = __builtin_amdgcn_readfirstlane(*slot);
        if (t >= PDG_NPAN * PDG_PARTS) break;
        const int panel = t / PDG_PARTS, r0 = t * 16 + F.wave * 2;
        if (((int)threadIdx.x) == 0) { unsigned sp = 0;
            while (__hip_atomic_load(qb + 1024 + 16 * panel, __ATOMIC_RELAXED, __HIP_MEMORY_SCOPE_AGENT) < 8u) { __builtin_amdgcn_s_sleep(2); if (++sp > (1u << 22)) break; } }
        __syncthreads();
        if (r0 < MROWS) xnorm_row2(F, layer, r0);
    }
}
__device__ __forceinline__ void pf_final(const Frame& F) {
    const int lane = ((int)threadIdx.x & 63);
    for (int r = F.vb * NWAVES + F.wave; r < MROWS; r += F.G * NWAVES) {
        float* dst;
        if (r >= MP_ROWS) dst = F.a->out + O_YS + (size_t)(r - MP_ROWS) * DM;
        else { const int b = r / LP, t = r - b * LP; if (t < NMETA) continue; dst = F.a->out + O_YP + ((size_t)b * SEQ + (t - NMETA)) * DM; }
        const float* x = ((float*)(F.a->ws + WS_XRES)) + (size_t)r * DM;
        f32x4 v[8]; float ss = 0.f;
#pragma unroll
        for (int i = 0; i < 8; ++i) { v[i] = *(const f32x4*)(x + i * 256 + lane * 4); ss += v[i][0] * v[i][0] + v[i][1] * v[i][1] + v[i][2] * v[i][2] + v[i][3] * v[i][3]; }
        ss = red64(ss);
        const float rs = rsqrtf(ss * (1.0f / DM) + 1e-6f);
#pragma unroll
        for (int i = 0; i < 8; ++i) { const f32x4 w = *(const f32x4*)(F.a->in[18] + i * 256 + lane * 4); *(f32x4*)(dst + i * 256 + lane * 4) = v[i] * rs * w; }
    }
}
__device__ __forceinline__ float dpp_sum16(float x) {
    x += __builtin_bit_cast(float, __builtin_amdgcn_update_dpp(0, __builtin_bit_cast(int, x), 0xB1, 0xF, 0xF, true));
    x += __builtin_bit_cast(float, __builtin_amdgcn_update_dpp(0, __builtin_bit_cast(int, x), 0x4E, 0xF, 0xF, true));
    x += __builtin_bit_cast(float, __builtin_amdgcn_update_dpp(0, __builtin_bit_cast(int, x), 0x141, 0xF, 0xF, true));
    x += __builtin_bit_cast(float, __builtin_amdgcn_update_dpp(0, __builtin_bit_cast(int, x), 0x140, 0xF, 0xF, true));
    return x;
}
__device__ __forceinline__ void cvt8(const uint4 w, float (&f)[8]) {
    f[0] = __builtin_bit_cast(float, w.x << 16); f[1] = __builtin_bit_cast(float, w.x & 0xffff0000u); f[2] = __builtin_bit_cast(float, w.y << 16); f[3] = __builtin_bit_cast(float, w.y & 0xffff0000u);
    f[4] = __builtin_bit_cast(float, w.z << 16); f[5] = __builtin_bit_cast(float, w.z & 0xffff0000u); f[6] = __builtin_bit_cast(float, w.w << 16); f[7] = __builtin_bit_cast(float, w.w & 0xffff0000u); }
__device__ __forceinline__ void lds8(const LAS float* p, float (&f)[8]) { const f32x4 a = *(const LAS f32x4*)p, c = *(const LAS f32x4*)(p + 4);
    f[0] = a[0]; f[1] = a[1]; f[2] = a[2]; f[3] = a[3]; f[4] = c[0]; f[5] = c[1]; f[6] = c[2]; f[7] = c[3]; }
constexpr int LQ = 0, LK = 4096, LF = 8192, LV = 12288, LAO = 16384, LOUT = 20480, LSC = 24576;
template <int TY, int EB>
__device__ __forceinline__ void scan_item(const Frame& F, int layer, int sample, int b, int h, int eb) {
    LAS float* L_ = (LAS float*)F.lds;
    constexpr int EW = 32 * EB;
    const int tid = ((int)threadIdx.x), el = tid >> 4, dl = tid & 15, tok = tid >> 4;
    const int L = sample ? DS : LP;
    const size_t row0 = sample ? (size_t)(MP_ROWS + b * DS) : (size_t)b * LP;
    constexpr int NH = TY == 2 ? HC : 6;
    const size_t sidx = (size_t)(layer * (sample ? DB : BATCH) + b) * NH + h;
    const int hcol = (TY == 0 ? 0 : TY == 1 ? 768 : 1536) + h * HD;
    const int qcol = (TY == 0 ? C_AQ : TY == 1 ? C_BQ : C_CQ) + h * HD + dl * 8, kcol = (TY == 0 ? C_AK : TY == 1 ? C_BK : C_CF) + h * HD + dl * 8;
    const int dv = dl & (4 * EB - 1);
    const int vcol = (TY == 0 ? C_AV : TY == 1 ? C_BV : C_CI) + h * HD + eb * 32 + dv * 8;
    const bool hasv = dl * 8 < EW;
    const bf16* proj = (const bf16*)(F.a->ws + WS_PROJ); const float* gates = (const float*)(F.a->ws + WS_GATES);
    float S[EB][8], nst[8]; float m_run = 0.f;
#pragma unroll
    for (int j = 0; j < 8; ++j) { nst[j] = 0.f;
#pragma unroll
        for (int i = 0; i < EB; ++i) S[i][j] = 0.f; }
    if (sample) {
        const float* S0 = (TY == 0 ? F.a->in[2] : TY == 1 ? F.a->in[5] : F.a->in[7]) + sidx * (HD * HD) + eb * 32;
#pragma unroll
        for (int i = 0; i < EB; ++i)
#pragma unroll
            for (int j = 0; j < 8; ++j) S[i][j] = S0[(dl * 8 + j) * HD + el + 32 * i];
        if (TY == 0) {
#pragma unroll
            for (int j = 0; j < 8; ++j) nst[j] = F.a->in[3][sidx * HD + dl * 8 + j];
            m_run = F.a->in[4][sidx]; }
    }
    uint4 rq[TY == 1 ? 4 : 1], rk[TY == 1 ? 4 : 1], rv[TY == 1 ? 4 : 1], ra; float g0 = 0.f, g1 = 0.f;
    ra = make_uint4(0, 0, 0, 0);
#define ISSUE_LOADS(T0) do { const int t_ = (T0) + tok; if (t_ < L) { const bf16* pr_ = proj + (row0 + t_) * NP; const float* gr_ = gates + (row0 + t_) * 32; \
        if (TY == 1) { _Pragma("unroll") for (int j_ = 0; j_ < 4; ++j_) { const int tau_ = t_ - 3 + j_; \
                if (tau_ >= 0) { const bf16* pj_ = proj + (row0 + tau_) * NP; rq[j_] = *(const uint4*)(pj_ + qcol); rk[j_] = *(const uint4*)(pj_ + kcol); rv[j_] = *(const uint4*)(pj_ + vcol); } \
                else { rq[j_] = make_uint4(0, 0, 0, 0); rk[j_] = rq[j_]; rv[j_] = rq[j_]; } } \
            g0 = gr_[12 + h]; g1 = gr_[18 + h]; } \
        else { rq[0] = *(const uint4*)(pr_ + qcol); rk[0] = *(const uint4*)(pr_ + kcol); rv[0] = *(const uint4*)(pr_ + vcol); \
            if (TY == 0) { ra = *(const uint4*)(pr_ + C_AO + h * HD + eb * 32 + dv * 8); g0 = gr_[h]; g1 = gr_[6 + h]; } } } } while (0)
    ISSUE_LOADS(0);
    for (int t0 = 0; t0 < L; t0 += 32) {
        __syncthreads();
        const int nt = (L - t0) < 32 ? (L - t0) : 32;
        {
            const int t = t0 + tok;
            if (t < L) {
                float q8[8], k8[8], f8[8], v8[8];
                if (TY == 0) {
                    cvt8(rq[0], q8); cvt8(rk[0], k8);
#pragma unroll
                    for (int j = 0; j < 8; ++j) k8[j] *= 0.08838834764831845f;
                    cvt8(rv[0], v8);
                    if (hasv) { float a8[8]; cvt8(ra, a8);
#pragma unroll
                        for (int j = 0; j < 8; ++j) L_[LAO + tok * EW + dl * 8 + j] = sigmoidf_(a8[j]); }
                    if (dl == 0) { L_[LSC + tok * 8 + 0] = g0 + F.a->in[11][layer * 12 + h]; L_[LSC + tok * 8 + 1] = logsigmoidf_(g1 + F.a->in[11][layer * 12 + 6 + h]); }
                } else if (TY == 1) {
                    float aq[8], ak[8], av[8];
#pragma unroll
                    for (int i = 0; i < 8; ++i) { aq[i] = 0.f; ak[i] = 0.f; av[i] = 0.f; }
#pragma unroll
                    for (int j = 0; j < 4; ++j) { const int tau = t - 3 + j; float uq[8], uk[8], uv[8];
                        const float* cw = F.a->in[14] + ((size_t)layer * 4 + j) * NCONV + h * HD + dl * 8;
                        if (sample && tau < 0) { const float* cs = F.a->in[6] + ((size_t)(layer * DB + b) * 3 + (3 + tau)) * NCONV + h * HD + dl * 8;
#pragma unroll
                            for (int i = 0; i < 8; ++i) { uq[i] = cs[i]; uk[i] = cs[768 + i]; uv[i] = cs[1536 + eb * 32 + (dv - dl) * 8 + i]; } }
                        else { cvt8(rq[j], uq); cvt8(rk[j], uk); cvt8(rv[j], uv); }
#pragma unroll
                        for (int i = 0; i < 8; ++i) { aq[i] += cw[i] * uq[i]; ak[i] += cw[768 + i] * uk[i]; av[i] += cw[1536 + eb * 32 + (dv - dl) * 8 + i] * uv[i]; } }
                    float sq = 0.f, sk = 0.f;
#pragma unroll
                    for (int i = 0; i < 8; ++i) { q8[i] = siluf_(aq[i]); k8[i] = siluf_(ak[i]); v8[i] = siluf_(av[i]); sq += q8[i] * q8[i]; sk += k8[i] * k8[i]; }
                    sq = dpp_sum16(sq); sk = dpp_sum16(sk);
                    const float rq_ = rsqrtf(sq + 1e-6f) * 0.08838834764831845f, rk_ = rsqrtf(sk + 1e-6f);
#pragma unroll
                    for (int j = 0; j < 8; ++j) { q8[j] *= rq_; k8[j] *= rk_; }
                    if (dl == 0) { const float g = -__expf(F.a->in[12][layer * HB + h]) * softplusf_(g0 + F.a->in[13][layer * HB + h]);
                        L_[LSC + tok * 8 + 0] = __expf(g); L_[LSC + tok * 8 + 1] = sigmoidf_(g1); }
                } else {
                    float c8[8]; cvt8(rq[0], q8); cvt8(rk[0], c8); cvt8(rv[0], v8);
#pragma unroll
                    for (int j = 0; j < 8; ++j) { const int ch = h * HD + dl * 8 + j;
                        const float lb = layer == 0 ? 0.f : 1.0f / (1.0f + __expf(F.a->in[15][ch] - F.a->in[15][512 + ch]));
                        const float sp = 1.0f / (1.0f + __expf(-c8[j])), sn = 1.0f / (1.0f + __expf(c8[j]));
                        f8[j] = lb + (1.0f - lb) * sp; k8[j] = (1.0f - lb) * sn; q8[j] = siluf_(q8[j]); }
                }
                float kq = 0.f;
#pragma unroll
                for (int j = 0; j < 8; ++j) kq += q8[j] * k8[j];
                kq = dpp_sum16(kq);
                if (dl == 0) L_[LSC + tok * 8 + 3] = kq;
#pragma unroll
                for (int j = 0; j < 8; ++j) { L_[LQ + tok * 128 + dl * 8 + j] = TY == 2 ? q8[j] * f8[j] : q8[j]; L_[LK + tok * 128 + dl * 8 + j] = k8[j]; if (TY == 2) L_[LF + tok * 128 + dl * 8 + j] = f8[j]; }
                if (hasv) {
#pragma unroll
                    for (int j = 0; j < 8; ++j) L_[LV + tok * EW + dl * 8 + j] = v8[j]; }
            }
        }
        if (TY == 0) {
            __syncthreads();
            if (F.wave == 0) {
                const int ln = ((int)threadIdx.x & 63); const bool valid = ln < nt;
                const float li = valid ? L_[LSC + (ln & 31) * 8 + 0] : -1e30f, lf = valid ? L_[LSC + (ln & 31) * 8 + 1] : 0.f;
                float Fc = lf;
#pragma unroll
                for (int d = 1; d < 32; d <<= 1) { const float t_ = __shfl_up(Fc, d); if (ln >= d) Fc += t_; }
                float pm = li - Fc;
#pragma unroll
                for (int d = 1; d < 32; d <<= 1) { const float t_ = __shfl_up(pm, d); if (ln >= d) pm = fmaxf(pm, t_); }
                const float mt = Fc + fmaxf(m_run, pm);
                float mprev = __shfl_up(mt, 1); if (ln == 0) mprev = m_run;
                if (valid) { L_[LSC + ln * 8 + 0] = __expf(lf + mprev - mt); L_[LSC + ln * 8 + 1] = __expf(li - mt); L_[LSC + ln * 8 + 2] = __expf(fminf(-mt, 60.f)); }
                m_run = __shfl(mt, nt - 1);
            }
        }
        __syncthreads();
        if (t0 + 32 < L) ISSUE_LOADS(t0 + 32);
        for (int tt = 0; tt < nt; ++tt) {
            float q[8], k[8], v[EB];
            lds8(L_ + LQ + tt * 128 + dl * 8, q); lds8(L_ + LK + tt * 128 + dl * 8, k);
            const f32x4 sc = *(const LAS f32x4*)(L_ + LSC + tt * 8);
#pragma unroll
            for (int i = 0; i < EB; ++i) v[i] = L_[LV + tt * EW + el + 32 * i];
            if (TY == 0) {
                const float fp = sc[0], ip = sc[1], emt = sc[2], kq = sc[3];
                float p[EB], nq = 0.f;
#pragma unroll
                for (int j = 0; j < 8; ++j) nq += nst[j] * q[j];
#pragma unroll
                for (int i = 0; i < EB; ++i) { p[i] = 0.f;
#pragma unroll
                    for (int j = 0; j < 8; ++j) p[i] += S[i][j] * q[j]; }
                nq = dpp_sum16(nq);
#pragma unroll
                for (int i = 0; i < EB; ++i) p[i] = dpp_sum16(p[i]);
                const float den = fp * nq + ip * kq, rden = 1.0f / fmaxf(fabsf(den), emt), ikq = ip * kq;
#pragma unroll
                for (int i = 0; i < EB; ++i) { if (dl == 0) L_[LOUT + tt * EW + el + 32 * i] = (fp * p[i] + ikq * v[i]) * rden; }
#pragma unroll
                for (int j = 0; j < 8; ++j) { const float ik = ip * k[j]; nst[j] = fp * nst[j] + ik;
#pragma unroll
                    for (int i = 0; i < EB; ++i) S[i][j] = fp * S[i][j] + ik * v[i]; }
            } else if (TY == 1) {
                const float a = sc[0], beta = sc[1], kq = sc[3];
                float u[EB], p[EB];
#pragma unroll
                for (int i = 0; i < EB; ++i) { u[i] = 0.f; p[i] = 0.f;
#pragma unroll
                    for (int j = 0; j < 8; ++j) { u[i] += S[i][j] * k[j]; p[i] += S[i][j] * q[j]; } }
#pragma unroll
                for (int i = 0; i < EB; ++i) { u[i] = dpp_sum16(u[i]); p[i] = dpp_sum16(p[i]); }
#pragma unroll
                for (int i = 0; i < EB; ++i) { const float w = v[i] - a * u[i]; if (dl == 0) L_[LOUT + tt * EW + el + 32 * i] = a * p[i] + beta * kq * w; const float bw = beta * w;
#pragma unroll
                    for (int j = 0; j < 8; ++j) S[i][j] = a * S[i][j] + k[j] * bw; }
            } else {
                const float kq = sc[3];
                float f[8]; lds8(L_ + LF + tt * 128 + dl * 8, f);
                float p[EB];
#pragma unroll
                for (int i = 0; i < EB; ++i) { p[i] = 0.f;
#pragma unroll
                    for (int j = 0; j < 8; ++j) p[i] += S[i][j] * q[j]; }
#pragma unroll
                for (int i = 0; i < EB; ++i) p[i] = dpp_sum16(p[i]);
#pragma unroll
                for (int i = 0; i < EB; ++i) { if (dl == 0) L_[LOUT + tt * EW + el + 32 * i] = p[i] + kq * v[i];
#pragma unroll
                    for (int j = 0; j < 8; ++j) S[i][j] = f[j] * S[i][j] + k[j] * v[i]; }
            }
        }
        __syncthreads();
        { bf16* hc = (bf16*)(F.a->ws + WS_HCAT) + (row0 + t0) * MIX + hcol + eb * 32;
          for (int idx = tid; idx < nt * EW; idx += NWAVES * 64) { const int tt = idx / EW, c = idx - tt * EW;
              float o = L_[LOUT + idx]; if (TY == 0) o *= L_[LAO + idx];
              hc[(size_t)tt * MIX + c] = (bf16)f2bf(o); } }
    }
#undef ISSUE_LOADS
    {
        float* So = F.a->out + (sample ? (TY == 0 ? O_MCS : TY == 1 ? O_GSS : O_HSS) : (TY == 0 ? O_MCP : TY == 1 ? O_GSP : O_HSP)) + sidx * (HD * HD) + eb * 32;
#pragma unroll
        for (int i = 0; i < EB; ++i)
#pragma unroll
            for (int j = 0; j < 8; ++j) So[(dl * 8 + j) * HD + el + 32 * i] = S[i][j];
        if (TY == 0 && eb == 0) {
            if (el == 0) { float* no = F.a->out + (sample ? O_MNS : O_MNP) + sidx * HD;
#pragma unroll
                for (int j = 0; j < 8; ++j) no[dl * 8 + j] = nst[j]; }
            if (tid == 0) F.a->out[(sample ? O_MMS : O_MMP) + sidx] = m_run;
        }
    }
}
typedef short bf16x8 __attribute__((ext_vector_type(8)));
typedef unsigned u32x4v __attribute__((ext_vector_type(4)));
typedef unsigned u32x2v __attribute__((ext_vector_type(2)));
__device__ __forceinline__ f32x4 mfma16(const u32x4v a, const u32x4v b, const f32x4 c) { return __builtin_amdgcn_mfma_f32_16x16x32_bf16(__builtin_bit_cast(bf16x8, a), __builtin_bit_cast(bf16x8, b), c, 0, 0, 0); }
__device__ __forceinline__ u32x2v tr_read8(unsigned lds_addr) { u32x2v r; asm volatile("ds_read_b64_tr_b16 %0, %1\n\ts_waitcnt lgkmcnt(0)" : "=&v"(r) : "v"(lds_addr) : "memory"); return r; }
__device__ __forceinline__ void tr_read8x8(unsigned a0, unsigned r7, u32x2v (&r)[8]) {
    const unsigned x = a0 ^ (r7 << 5);
    asm volatile("ds_read_b64_tr_b16 %0, %8\n\tds_read_b64_tr_b16 %1, %9\n\tds_read_b64_tr_b16 %2, %10\n\tds_read_b64_tr_b16 %3, %11\n\t"
                 "ds_read_b64_tr_b16 %4, %12\n\tds_read_b64_tr_b16 %5, %13\n\tds_read_b64_tr_b16 %6, %14\n\tds_read_b64_tr_b16 %7, %15\n\ts_waitcnt lgkmcnt(0)"
                 : "=&v"(r[0]), "=&v"(r[1]), "=&v"(r[2]), "=&v"(r[3]), "=&v"(r[4]), "=&v"(r[5]), "=&v"(r[6]), "=&v"(r[7])
                 : "v"(x), "v"(x ^ 32u), "v"(x ^ 64u), "v"(x ^ 96u), "v"(x ^ 128u), "v"(x ^ 160u), "v"(x ^ 192u), "v"(x ^ 224u) : "memory"); }
#define DPP_F(x, ctrl, oldv, bc) __builtin_bit_cast(float, __builtin_amdgcn_update_dpp(__builtin_bit_cast(int, (float)(oldv)), __builtin_bit_cast(int, (float)(x)), (ctrl), 0xF, 0xF, (bc)))
__device__ __forceinline__ float row_cumsum16(float x) { x += DPP_F(x, 0x111, 0.f, true); x += DPP_F(x, 0x112, 0.f, true); x += DPP_F(x, 0x114, 0.f, true); x += DPP_F(x, 0x118, 0.f, true); return x; }
__device__ __forceinline__ float row_cummax16(float x) { x = fmaxf(x, DPP_F(x, 0x111, -3.0e38f, false)); x = fmaxf(x, DPP_F(x, 0x112, -3.0e38f, false)); x = fmaxf(x, DPP_F(x, 0x114, -3.0e38f, false)); x = fmaxf(x, DPP_F(x, 0x118, -3.0e38f, false)); return x; }
__device__ __forceinline__ float bflo(unsigned w) { return __builtin_bit_cast(float, w << 16); }
__device__ __forceinline__ float bfhi(unsigned w) { return __builtin_bit_cast(float, w & 0xffff0000u); }
__device__ __forceinline__ void wait_vm(int n) {
    if (n >= 10) asm volatile("s_waitcnt vmcnt(10)" ::: "memory");
    else if (n >= 8) asm volatile("s_waitcnt vmcnt(8)" ::: "memory");
    else if (n >= 6) asm volatile("s_waitcnt vmcnt(6)" ::: "memory");
    else if (n >= 4) asm volatile("s_waitcnt vmcnt(4)" ::: "memory");
    else if (n >= 3) asm volatile("s_waitcnt vmcnt(3)" ::: "memory");
    else if (n >= 2) asm volatile("s_waitcnt vmcnt(2)" ::: "memory");
    else if (n >= 1) asm volatile("s_waitcnt vmcnt(1)" ::: "memory");
    else asm volatile("s_waitcnt vmcnt(0)" ::: "memory");
}
#define SEQ_NB 4
#define SEQ_D 3
#define SEQ_STEP_END(j, nch, PW) do { if ((PW) > 0 && (j) + 1 < (nch)) { const int last_ = ((j) + SEQ_D < (nch) - 1) ? (j) + SEQ_D : (nch) - 1; wait_vm((PW) * (last_ - ((j) + 1))); } \
        asm volatile("s_waitcnt lgkmcnt(0)" ::: "memory"); __builtin_amdgcn_s_barrier(); asm volatile("" ::: "memory"); } while (0)
#define SEQ_PROLOGUE(STAGE, nch, PW) do { _Pragma("unroll") for (int j0_ = 0; j0_ < SEQ_D; ++j0_) if (j0_ < (nch)) STAGE(j0_); \
        if ((PW) > 0) { const int last_ = (SEQ_D - 1 < (nch) - 1) ? SEQ_D - 1 : (nch) - 1; wait_vm((PW) * last_); } \
        asm volatile("s_waitcnt lgkmcnt(0)" ::: "memory"); __builtin_amdgcn_s_barrier(); asm volatile("" ::: "memory"); } while (0)
constexpr int NCH_P = LP / 16;
#define WS_BLOB_A (WS_WIN + (size_t)layer * NPG * DM * 2)
constexpr int BLOB_A = 6144;
constexpr int NSEQ_AP = BATCH * HA, NSEQ_AS = DB * HA;
static_assert((size_t)(NSEQ_AP * NCH_P + NSEQ_AS) * BLOB_A <= (size_t)NMAIN * DM * 2, "mLSTM blobs fit the dead part of the weight copy");
__device__ __forceinline__ bool slot_row(int sample, int b, int chunk, int slot, size_t& row) {
    if (!sample) { row = (size_t)b * LP + chunk * 16 + slot; return true; }
    row = (size_t)MP_ROWS + b * DS + (slot >= 8 ? slot - 8 : 0); return slot >= 8;
}
constexpr int SB_OFF = 40960;
struct Pref { int pre, nxt, nb, nh, par; };
__device__ __forceinline__ void state_dma(const Frame& F, const float* src) {
#pragma unroll
    for (int i = 0; i < 8; ++i) { const int pc = F.wave * 8 + i, ln = ((int)threadIdx.x & 63), row = 2 * pc + (ln >> 5);
        __builtin_amdgcn_global_load_lds((const unsigned*)((const unsigned char*)src + row * 512 + (((ln & 31) ^ (((row >> 2) & 3) << 2)) << 4)), (LAS unsigned*)(F.lds + SB_OFF + pc * 1024), 16, 0, 0); }
}
__device__ __forceinline__ void state_to_acc(const Frame& F, f32x4 (&S)[8]) {
    const int c = ((int)threadIdx.x & 63) & 15, g = ((int)threadIdx.x & 63) >> 4;
    const LAS float* sb = (const LAS float*)(F.lds + SB_OFF) + 16 * (F.wave ^ g) + c;
#pragma unroll
    for (int d = 0; d < 8; ++d)
#pragma unroll
        for (int r = 0; r < 4; ++r) S[d][r] = sb[(16 * d + 4 * g + r) * HD];
}
#define SEQ_SYNC() do { asm volatile("s_waitcnt lgkmcnt(0)" ::: "memory"); __builtin_amdgcn_s_barrier(); asm volatile("" ::: "memory"); } while (0)
__device__ __forceinline__ void acc_to_state_store(const Frame& F, const f32x4 (&S)[8], float* dst) {
    const int c = ((int)threadIdx.x & 63) & 15, g = ((int)threadIdx.x & 63) >> 4;
    LAS float* sb = (LAS float*)(F.lds + SB_OFF) + 16 * (F.wave ^ g) + c;
#pragma unroll
    for (int d = 0; d < 8; ++d)
#pragma unroll
        for (int r = 0; r < 4; ++r) sb[(16 * d + 4 * g + r) * HD] = S[d][r];
    SEQ_SYNC();
#pragma unroll
    for (int i = 0; i < 8; ++i) { const int pc = F.wave * 8 + i, ln = ((int)threadIdx.x & 63), row = 2 * pc + (ln >> 5);
        *(u32x4v*)((unsigned char*)dst + row * 512 + (((ln & 31) ^ (((row >> 2) & 3) << 2)) << 4)) = *(const LAS u32x4v*)(F.lds + SB_OFF + pc * 1024 + ln * 16); }
}
__device__ __forceinline__ void mlstm_pre(const Frame& F, int layer, int sample, int b, int h, int chunk, unsigned char* blob) {
    const int l = ((int)threadIdx.x & 63), c = l & 15, g = l >> 4;
    const bf16* proj = (const bf16*)(F.a->ws + WS_PROJ); const float* gates = (const float*)(F.a->ws + WS_GATES);
    size_t row; const bool valid = slot_row(sample, b, chunk, c, row);
    const float li = valid ? gates[row * 32 + h] + F.a->in[11][layer * 12 + h] : -1e30f;
    const float lf = valid ? logsigmoidf_(gates[row * 32 + 6 + h] + F.a->in[11][layer * 12 + 6 + h]) : 0.f;
    const float Fc = row_cumsum16(lf), gv = li - Fc, R = row_cummax16(gv);
    u32x4v qf[4], kf[4];
    const bf16* qp = proj + row * NP + C_AQ + h * HD + 4 * g; const bf16* kp = proj + row * NP + C_AK + h * HD + 4 * g;
#pragma unroll
    for (int kk = 0; kk < 4; ++kk) { const uint2 q0 = *(const uint2*)(qp + 32 * kk), q1 = *(const uint2*)(qp + 32 * kk + 16), k0 = *(const uint2*)(kp + 32 * kk), k1 = *(const uint2*)(kp + 32 * kk + 16);
        qf[kk] = (u32x4v){q0.x, q0.y, q1.x, q1.y}; kf[kk] = (u32x4v){k0.x, k0.y, k1.x, k1.y}; }
    f32x4 st = (f32x4){0.f, 0.f, 0.f, 0.f};
#pragma unroll
    for (int kk = 0; kk < 4; ++kk) st = mfma16(kf[kk], qf[kk], st);
    const float scale = 0.08838834764831845f;
    float P[4]; float rs = 0.f;
#pragma unroll
    for (int r = 0; r < 4; ++r) { const int s = 4 * g + r; const float gs = __shfl(gv, (l & 48) | s);
        P[r] = (s <= c) ? __expf(gs - R) * st[r] * scale : 0.f; rs += P[r]; }
    rs += __shfl_xor(rs, 16); rs += __shfl_xor(rs, 32);
    *(u32x4v*)(blob + l * 16) = (u32x4v){pk2(P[0], P[1]), pk2(P[2], P[3]), 0u, 0u};
    const float R15 = __shfl(R, (l & 48) | 15);
    const float wK = valid ? __expf(gv - R15) * scale : 0.f;
    unsigned char* kimg = blob + 1024; float* dn = (float*)(blob + 5120);
#pragma unroll
    for (int kk = 0; kk < 4; ++kk)
#pragma unroll
        for (int hh = 0; hh < 2; ++hh) { const unsigned w0 = hh ? kf[kk][2] : kf[kk][0], w1 = hh ? kf[kk][3] : kf[kk][1];
            const float v0 = bflo(w0) * wK, v1 = bfhi(w0) * wK, v2 = bflo(w1) * wK, v3 = bfhi(w1) * wK;
            const int d = 32 * kk + 16 * hh + 4 * g;
            *(uint2*)(kimg + c * 256 + ((d * 2) ^ ((c & 7) << 5))) = make_uint2(pk2(v0, v1), pk2(v2, v3));
            const float s0 = dpp_sum16(v0), s1 = dpp_sum16(v1), s2 = dpp_sum16(v2), s3 = dpp_sum16(v3);
            if (c == 0) *(f32x4*)(dn + d) = (f32x4){s0, s1, s2, s3}; }
    if (g == 0) { float* sc = (float*)(blob + 5632); sc[c] = R; sc[16 + c] = Fc; sc[32 + c] = rs; }
}
constexpr int SQ_BUF = 14336;
__device__ __forceinline__ void mlstm_seq(const Frame& F, int layer, int sample, int b, int h, int half, const Pref pf) {
    const int l = ((int)threadIdx.x & 63), c = l & 15, g = l >> 4, w = F.wave;
    const bool split = half >= 0; const int et = split ? half * 4 + (w & 3) : w; const bool comp = !split || w < 4; const int lw = split ? w - 4 : w, nl = split ? 4 : 8;
    const bf16* proj = (const bf16*)(F.a->ws + WS_PROJ);
    const int nch = sample ? 1 : NCH_P;
    const size_t sidx = (size_t)(layer * (sample ? DB : BATCH) + b) * HA + h;
    const unsigned char* blob0 = F.a->ws + WS_BLOB_A + (size_t)(sample ? NSEQ_AP * NCH_P + b * HA + h : (b * HA + h) * NCH_P) * BLOB_A;
    f32x4 C[8], nrep[8]; float m = 0.f;
#pragma unroll
    for (int d = 0; d < 8; ++d) { C[d] = (f32x4){0.f, 0.f, 0.f, 0.f}; nrep[d] = C[d]; }
#define MSEQ_STAGE_TO(bi_, sb_, sh_, j, blobj_) do { LAS unsigned char* bufp_ = F.lds + (bi_) * SQ_BUF; \
        _Pragma("unroll") for (int pi_ = 0; pi_ < 4; ++pi_) { const int pc_ = lw + nl * pi_; if (lw >= 0 && pc_ < 14) { const unsigned char* src_; \
            if (pc_ < 8) { const int im_ = pc_ >> 2, slot_ = 4 * (pc_ & 3) + g; size_t row_; (void)slot_row(sample, (sb_), (j), slot_, row_); \
                src_ = (const unsigned char*)(proj + row_ * NP + (im_ == 0 ? C_AQ : C_AV) + (sh_) * HD + (c ^ ((slot_ & 7) << 1)) * 8); } \
            else src_ = (blobj_) + (pc_ - 8) * 1024 + l * 16; \
            __builtin_amdgcn_global_load_lds((const unsigned*)src_, (LAS unsigned*)(bufp_ + pc_ * 1024), 16, 0, 0); } } } while (0)
#define MSEQ_STAGE(j) MSEQ_STAGE_TO((j) % SEQ_NB, b, h, (j), blob0 + (size_t)(j) * BLOB_A)
    if (sample) {
        const float* n0 = F.a->in[3] + sidx * HD;
#pragma unroll
        for (int d = 0; d < 8; ++d) nrep[d] = *(const f32x4*)(n0 + 16 * d + 4 * g);
        m = F.a->in[4][sidx];
        if (!pf.pre) { __syncthreads(); state_dma(F, F.a->in[2] + sidx * (HD * HD)); MSEQ_STAGE_TO(pf.par, b, h, 0, blob0); }
        wait_vm(0); SEQ_SYNC();
        state_to_acc(F, C);
        SEQ_SYNC();
        if (pf.nxt) { const size_t nidx = (size_t)(layer * DB + pf.nb) * HA + pf.nh;
            state_dma(F, F.a->in[2] + nidx * (HD * HD)); MSEQ_STAGE_TO(pf.par ^ 1, pf.nb, pf.nh, 0, F.a->ws + WS_BLOB_A + (size_t)(NSEQ_AP * NCH_P + pf.nb * HA + pf.nh) * BLOB_A); }
    } else __syncthreads();
    const int PW = lw < 0 ? 0 : (14 - lw + nl - 1) / nl;
    const bool nwave = !split && w == 0;
    if (!sample) SEQ_PROLOGUE(MSEQ_STAGE, nch, PW);
    for (int j = 0; j < nch; ++j) {
        if (!sample && j + SEQ_D < nch) MSEQ_STAGE(j + SEQ_D);
        if (comp || nwave) {
        LAS unsigned char* buf = F.lds + (sample ? pf.par : j % SEQ_NB) * SQ_BUF;
        const unsigned bufa = (unsigned)(size_t)buf;
        LAS unsigned char* bl = buf + 8192;
        const f32x4 R4 = *(const LAS f32x4*)(bl + 5632 + 16 * g), F4 = *(const LAS f32x4*)(bl + 5696 + 16 * g), rs4 = *(const LAS f32x4*)(bl + 5760 + 16 * g);
        const float R15 = *(const LAS float*)(bl + 5632 + 60), F15 = *(const LAS float*)(bl + 5696 + 60);
        const float M15 = fmaxf(m, R15), e15 = __expf(-fabsf(m - R15)), aC = m >= R15 ? 1.f : e15, aD = m >= R15 ? e15 : 1.f;
        f32x4 c1v, c2v;
#pragma unroll
        for (int r = 0; r < 4; ++r) { const float e = __expf(-fabsf(m - R4[r])); const bool ge = m >= R4[r]; c1v[r] = ge ? 1.f : e; c2v[r] = ge ? e : 1.f; }
        if (nwave) {
            f32x4 accn = (f32x4){0.f, 0.f, 0.f, 0.f};
#pragma unroll
            for (int kk = 0; kk < 4; ++kk) {
                const u32x2v q0 = *(const LAS u32x2v*)(buf + c * 256 + ((64 * kk + 8 * g) ^ ((c & 7) << 5))), q1 = *(const LAS u32x2v*)(buf + c * 256 + ((64 * kk + 32 + 8 * g) ^ ((c & 7) << 5)));
                const u32x4v nf = (u32x4v){pk2(nrep[2 * kk][0], nrep[2 * kk][1]), pk2(nrep[2 * kk][2], nrep[2 * kk][3]), pk2(nrep[2 * kk + 1][0], nrep[2 * kk + 1][1]), pk2(nrep[2 * kk + 1][2], nrep[2 * kk + 1][3])};
                accn = mfma16((u32x4v){q0[0], q0[1], q1[0], q1[1]}, nf, accn);
            }
            float* dn_out = (float*)(F.a->ws + WS_GATES) + 24 + h;
#pragma unroll
            for (int r = 0; r < 4; ++r) { const float Mt = fmaxf(m, R4[r]), emt = __expf(fminf(-(F4[r] + Mt), 60.f)), den = c1v[r] * accn[r] + c2v[r] * rs4[r];
                size_t row; const bool valid = slot_row(sample, b, j, 4 * g + r, row);
                if (valid && c == 0) dn_out[row * 32] = fmaxf(fabsf(den), emt); }
#pragma unroll
            for (int d = 0; d < 8; ++d) { const f32x4 dn4 = *(const LAS f32x4*)(bl + 5120 + (16 * d + 4 * g) * 4); nrep[d] = nrep[d] * aC + dn4 * aD; }
        }
        if (comp) {
        f32x4 acc1 = (f32x4){0.f, 0.f, 0.f, 0.f}, acc2 = acc1;
#pragma unroll
        for (int kk = 0; kk < 4; ++kk) {
            const u32x2v q0 = *(const LAS u32x2v*)(buf + c * 256 + ((64 * kk + 8 * g) ^ ((c & 7) << 5))), q1 = *(const LAS u32x2v*)(buf + c * 256 + ((64 * kk + 32 + 8 * g) ^ ((c & 7) << 5)));
            const u32x4v qf = (u32x4v){q0[0], q0[1], q1[0], q1[1]};
            const u32x4v cf = (u32x4v){pk2(C[2 * kk][0], C[2 * kk][1]), pk2(C[2 * kk][2], C[2 * kk][3]), pk2(C[2 * kk + 1][0], C[2 * kk + 1][1]), pk2(C[2 * kk + 1][2], C[2 * kk + 1][3])};
            acc1 = mfma16(qf, cf, acc1);
        }
        const unsigned tra = bufa + (unsigned)((4 * g + (c >> 2)) * 256 + (c & 3) * 8), r7 = (unsigned)((4 * g + (c >> 2)) & 7);
        const u32x2v vt = tr_read8(tra + 4096 + 32 * ((unsigned)et ^ r7));
        const u32x4v vf = (u32x4v){vt[0], vt[1], 0u, 0u};
        const u32x4v pf = *(const LAS u32x4v*)(bl + l * 16);
        acc2 = mfma16(pf, vf, acc2);
        {
            bf16* hc = (bf16*)(F.a->ws + WS_HCAT);
#pragma unroll
            for (int r = 0; r < 4; ++r) { size_t row; const bool valid = slot_row(sample, b, j, 4 * g + r, row);
                if (valid) hc[row * MIX + h * HD + 16 * et + c] = (bf16)f2bf(c1v[r] * acc1[r] + c2v[r] * acc2[r]); }
        }
        u32x2v ktr[8]; tr_read8x8(tra + 8192 + 1024, r7, ktr);
        const u32x4v vfd = (u32x4v){pk2(bflo(vt[0]) * aD, bfhi(vt[0]) * aD), pk2(bflo(vt[1]) * aD, bfhi(vt[1]) * aD), 0u, 0u};
#pragma unroll
        for (int d = 0; d < 8; ++d) C[d] = mfma16((u32x4v){ktr[d][0], ktr[d][1], 0u, 0u}, vfd, C[d] * aC);
        }
        m = F15 + M15;
        }
        if (!sample) SEQ_STEP_END(j, nch, PW);
    }
#undef MSEQ_STAGE
#undef MSEQ_STAGE_TO
    {
        if (sample) acc_to_state_store(F, C, F.a->out + O_MCS + sidx * (HD * HD));
        else if (comp) { float* Co = F.a->out + (sample ? O_MCS : O_MCP) + sidx * (HD * HD) + 16 * et + c;
#pragma unroll
        for (int d = 0; d < 8; ++d)
#pragma unroll
            for (int r = 0; r < 4; ++r) Co[(16 * d + 4 * g + r) * HD] = C[d][r]; }
        if (nwave && c == 0) { float* no = F.a->out + (sample ? O_MNS : O_MNP) + sidx * HD;
#pragma unroll
            for (int d = 0; d < 8; ++d)
#pragma unroll
                for (int r = 0; r < 4; ++r) no[16 * d + 4 * g + r] = nrep[d][r]; }
        if (nwave && l == 0) F.a->out[(sample ? O_MMS : O_MMP) + sidx] = m;
    }
}
__device__ __forceinline__ void mlstm_nwalk(const Frame& F, int layer, int b, int h) {
    const int l = ((int)threadIdx.x & 63), c = l & 15, g = l >> 4;
    const bf16* proj = (const bf16*)(F.a->ws + WS_PROJ);
    const size_t sidx = (size_t)(layer * BATCH + b) * HA + h;
    const unsigned char* blob0 = F.a->ws + WS_BLOB_A + (size_t)((b * HA + h) * NCH_P) * BLOB_A;
    LAS unsigned char* base = F.lds + F.wave * 16384;
    f32x4 nrep[8]; float m = 0.f;
#pragma unroll
    for (int d = 0; d < 8; ++d) nrep[d] = (f32x4){0.f, 0.f, 0.f, 0.f};
#define NW_STAGE(j) do { LAS unsigned char* bufp_ = base + ((j) % 3) * 5120; \
        _Pragma("unroll") for (int pc_ = 0; pc_ < 4; ++pc_) { const int slot_ = 4 * pc_ + g; \
            __builtin_amdgcn_global_load_lds((const unsigned*)(proj + ((size_t)b * LP + (j) * 16 + slot_) * NP + C_AQ + h * HD + (c ^ ((slot_ & 7) << 1)) * 8), (LAS unsigned*)(bufp_ + pc_ * 1024), 16, 0, 0); } \
        __builtin_amdgcn_global_load_lds((const unsigned*)(blob0 + (size_t)(j) * BLOB_A + 5120 + l * 16), (LAS unsigned*)(bufp_ + 4096), 16, 0, 0); } while (0)
    NW_STAGE(0); NW_STAGE(1);
    float* dn_out = (float*)(F.a->ws + WS_GATES) + 24 + h;
    for (int j = 0; j < NCH_P; ++j) {
        if (j + 2 < NCH_P) { NW_STAGE(j + 2); asm volatile("s_waitcnt vmcnt(10)" ::: "memory"); }
        else if (j + 1 < NCH_P) asm volatile("s_waitcnt vmcnt(5)" ::: "memory");
        else asm volatile("s_waitcnt vmcnt(0)" ::: "memory");
        LAS unsigned char* buf = base + (j % 3) * 5120; LAS unsigned char* bt = buf + 4096;
        const f32x4 R4 = *(const LAS f32x4*)(bt + 512 + 16 * g), F4 = *(const LAS f32x4*)(bt + 576 + 16 * g), rs4 = *(const LAS f32x4*)(bt + 640 + 16 * g);
        const float R15 = *(const LAS float*)(bt + 512 + 60), F15 = *(const LAS float*)(bt + 576 + 60);
        const float M15 = fmaxf(m, R15), e15 = __expf(-fabsf(m - R15)), aC = m >= R15 ? 1.f : e15, aD = m >= R15 ? e15 : 1.f;
        f32x4 accn = (f32x4){0.f, 0.f, 0.f, 0.f};
#pragma unroll
        for (int kk = 0; kk < 4; ++kk) {
            const u32x2v q0 = *(const LAS u32x2v*)(buf + c * 256 + ((64 * kk + 8 * g) ^ ((c & 7) << 5))), q1 = *(const LAS u32x2v*)(buf + c * 256 + ((64 * kk + 32 + 8 * g) ^ ((c & 7) << 5)));
            const u32x4v nf = (u32x4v){pk2(nrep[2 * kk][0], nrep[2 * kk][1]), pk2(nrep[2 * kk][2], nrep[2 * kk][3]), pk2(nrep[2 * kk + 1][0], nrep[2 * kk + 1][1]), pk2(nrep[2 * kk + 1][2], nrep[2 * kk + 1][3])};
            accn = mfma16((u32x4v){q0[0], q0[1], q1[0], q1[1]}, nf, accn);
        }
#pragma unroll
        for (int r = 0; r < 4; ++r) { const float Mt = fmaxf(m, R4[r]), e = __expf(-fabsf(m - R4[r])), c1 = m >= R4[r] ? 1.f : e, c2 = m >= R4[r] ? e : 1.f;
            const float emt = __expf(fminf(-(F4[r] + Mt), 60.f)), den = c1 * accn[r] + c2 * rs4[r];
            if (c == 0) dn_out[((size_t)b * LP + j * 16 + 4 * g + r) * 32] = fmaxf(fabsf(den), emt); }
#pragma unroll
        for (int d = 0; d < 8; ++d) { const f32x4 dn4 = *(const LAS f32x4*)(bt + (16 * d + 4 * g) * 4); nrep[d] = nrep[d] * aC + dn4 * aD; }
        m = F15 + M15;
        asm volatile("s_waitcnt lgkmcnt(0)" ::: "memory");
    }
#undef NW_STAGE
    if (c == 0) { float* no = F.a->out + O_MNP + sidx * HD;
#pragma unroll
        for (int d = 0; d < 8; ++d)
#pragma unroll
            for (int r = 0; r < 4; ++r) no[16 * d + 4 * g + r] = nrep[d][r]; }
    if (l == 0) F.a->out[O_MMP + sidx] = m;
}
constexpr int BLOB_C = 10240;
constexpr int NSEQ_CP = BATCH * HC, NSEQ_CS = DB * HC;
static_assert(WS_BLOB_C + (size_t)(NSEQ_CP * NCH_P + NSEQ_CS) * BLOB_C <= WS_BLOB_B, "HGRN2 blobs");
__device__ __forceinline__ void hgrn_pre(const Frame& F, int layer, int sample, int b, int h, int chunk, unsigned char* blob) {
    const int l = ((int)threadIdx.x & 63), c = l & 15, g = l >> 4;
    const bf16* proj = (const bf16*)(F.a->ws + WS_PROJ);
    size_t row; const bool valid = slot_row(sample, b, chunk, c, row);
    const bf16* qp = proj + row * NP + C_CQ + h * HD + 4 * g; const bf16* fp = proj + row * NP + C_CF + h * HD + 4 * g;
    unsigned char* kimg = blob + 5120; float* Dp = (float*)(blob + 9216);
    u32x4v qf[4], kf[4];
#pragma unroll
    for (int kk = 0; kk < 4; ++kk)
#pragma unroll
        for (int hh = 0; hh < 2; ++hh) {
            const int d = 32 * kk + 16 * hh + 4 * g;
            const uint2 qw = *(const uint2*)(qp + 32 * kk + 16 * hh), fw = *(const uint2*)(fp + 32 * kk + 16 * hh);
            const float cq[4] = {bflo(qw.x), bfhi(qw.x), bflo(qw.y), bfhi(qw.y)}, cf[4] = {bflo(fw.x), bfhi(fw.x), bflo(fw.y), bfhi(fw.y)};
            float qt[4], kh[4], kt[4], D4[4];
#pragma unroll
            for (int i = 0; i < 4; ++i) { const int ch = h * HD + d + i;
                const float lb = layer == 0 ? 0.f : 1.0f / (1.0f + __expf(F.a->in[15][ch] - F.a->in[15][512 + ch]));
                const float sp = __builtin_amdgcn_rcpf(1.0f + __expf(-cf[i])), sn = __builtin_amdgcn_rcpf(1.0f + __expf(cf[i]));
                const float f = lb + (1.0f - lb) * sp;
                const float lg = valid ? __logf(f) : 0.f, kv = valid ? (1.0f - lb) * sn : 0.f, qv = valid ? siluf_(cq[i]) : 0.f;
                const float bt = row_cumsum16(lg), b15 = dpp_sum16(lg);
                qt[i] = qv * __expf(bt); kh[i] = kv * __expf(fminf(-bt, 80.f)); kt[i] = kv * __expf(b15 - bt); D4[i] = __expf(b15); }
            const unsigned q0 = pk2(qt[0], qt[1]), q1 = pk2(qt[2], qt[3]), k0 = pk2(kh[0], kh[1]), k1 = pk2(kh[2], kh[3]);
            if (hh == 0) { qf[kk][0] = q0; qf[kk][1] = q1; kf[kk][0] = k0; kf[kk][1] = k1; } else { qf[kk][2] = q0; qf[kk][3] = q1; kf[kk][2] = k0; kf[kk][3] = k1; }
            *(uint2*)(kimg + c * 256 + ((d * 2) ^ ((c & 7) << 5))) = make_uint2(pk2(kt[0], kt[1]), pk2(kt[2], kt[3]));
            if (c == 0) *(f32x4*)(Dp + d) = (f32x4){D4[0], D4[1], D4[2], D4[3]};
        }
    f32x4 at = (f32x4){0.f, 0.f, 0.f, 0.f};
#pragma unroll
    for (int kk = 0; kk < 4; ++kk) at = mfma16(kf[kk], qf[kk], at);
    float P[4];
#pragma unroll
    for (int r = 0; r < 4; ++r) P[r] = (4 * g + r <= c) ? at[r] : 0.f;
    *(u32x4v*)(blob + l * 16) = (u32x4v){pk2(P[0], P[1]), pk2(P[2], P[3]), 0u, 0u};
#pragma unroll
    for (int kk = 0; kk < 4; ++kk) *(u32x4v*)(blob + 1024 + kk * 1024 + l * 16) = qf[kk];
}
constexpr int SQC_BUF = 14336;
__device__ __forceinline__ void hgrn_seq(const Frame& F, int layer, int sample, int b, int h, int half, const Pref pf) {
    const int l = ((int)threadIdx.x & 63), c = l & 15, g = l >> 4, w = F.wave;
    const bool split = half >= 0; const int et = split ? half * 4 + (w & 3) : w; const bool comp = !split || w < 4; const int lw = split ? w - 4 : w, nl = split ? 4 : 8;
    const bf16* proj = (const bf16*)(F.a->ws + WS_PROJ);
    const int nch = sample ? 1 : NCH_P;
    const size_t sidx = (size_t)(layer * (sample ? DB : BATCH) + b) * HC + h;
    const unsigned char* blob0 = F.a->ws + WS_BLOB_C + (size_t)(sample ? NSEQ_CP * NCH_P + b * HC + h : (b * HC + h) * NCH_P) * BLOB_C;
    f32x4 S[8];
#pragma unroll
    for (int d = 0; d < 8; ++d) S[d] = (f32x4){0.f, 0.f, 0.f, 0.f};
#define CSEQ_STAGE_TO(bi_, sb_, sh_, j, blobj_) do { LAS unsigned char* bufp_ = F.lds + (bi_) * SQC_BUF; \
        _Pragma("unroll") for (int pi_ = 0; pi_ < 4; ++pi_) { const int pc_ = lw + nl * pi_; if (lw >= 0 && pc_ < 14) { const unsigned char* src_; \
            if (pc_ < 4) { size_t row_; (void)slot_row(sample, (sb_), (j), 4 * pc_ + g, row_); src_ = (const unsigned char*)(proj + row_ * NP + C_CI + (sh_) * HD + (c ^ (((4 * pc_ + g) & 7) << 1)) * 8); } \
            else src_ = (blobj_) + (pc_ - 4) * 1024 + l * 16; \
            __builtin_amdgcn_global_load_lds((const unsigned*)src_, (LAS unsigned*)(bufp_ + pc_ * 1024), 16, 0, 0); } } } while (0)
#define CSEQ_STAGE(j) CSEQ_STAGE_TO((j) % SEQ_NB, b, h, (j), blob0 + (size_t)(j) * BLOB_C)
    if (sample) {
        if (!pf.pre) { __syncthreads(); state_dma(F, F.a->in[7] + sidx * (HD * HD)); CSEQ_STAGE_TO(pf.par, b, h, 0, blob0); }
        wait_vm(0); SEQ_SYNC();
        state_to_acc(F, S);
        SEQ_SYNC();
        if (pf.nxt) { const size_t nidx = (size_t)(layer * DB + pf.nb) * HC + pf.nh;
            state_dma(F, F.a->in[7] + nidx * (HD * HD)); CSEQ_STAGE_TO(pf.par ^ 1, pf.nb, pf.nh, 0, F.a->ws + WS_BLOB_C + (size_t)(NSEQ_CP * NCH_P + pf.nb * HC + pf.nh) * BLOB_C); }
    } else __syncthreads();
    const int PW = lw < 0 ? 0 : (14 - lw + nl - 1) / nl;
    if (!sample) SEQ_PROLOGUE(CSEQ_STAGE, nch, PW);
    for (int j = 0; j < nch; ++j) {
        if (!sample && j + SEQ_D < nch) CSEQ_STAGE(j + SEQ_D);
        if (comp) {
        LAS unsigned char* buf = F.lds + (sample ? pf.par : j % SEQ_NB) * SQC_BUF;
        const unsigned bufa = (unsigned)(size_t)buf;
        LAS unsigned char* bl = buf + 4096;
        f32x4 acc = (f32x4){0.f, 0.f, 0.f, 0.f};
#pragma unroll
        for (int kk = 0; kk < 4; ++kk) {
            const u32x4v qf = *(const LAS u32x4v*)(bl + 1024 + kk * 1024 + l * 16);
            const u32x4v sf = (u32x4v){pk2(S[2 * kk][0], S[2 * kk][1]), pk2(S[2 * kk][2], S[2 * kk][3]), pk2(S[2 * kk + 1][0], S[2 * kk + 1][1]), pk2(S[2 * kk + 1][2], S[2 * kk + 1][3])};
            acc = mfma16(qf, sf, acc);
        }
        const unsigned tra = bufa + (unsigned)((4 * g + (c >> 2)) * 256 + (c & 3) * 8), r7 = (unsigned)((4 * g + (c >> 2)) & 7);
        const u32x2v vt = tr_read8(tra + 32 * ((unsigned)et ^ r7));
        const u32x4v vf = (u32x4v){vt[0], vt[1], 0u, 0u};
        acc = mfma16(*(const LAS u32x4v*)(bl + l * 16), vf, acc);
        {
            bf16* hc = (bf16*)(F.a->ws + WS_HCAT);
#pragma unroll
            for (int r = 0; r < 4; ++r) { size_t row; const bool valid = slot_row(sample, b, j, 4 * g + r, row);
                if (valid) hc[row * MIX + 1536 + h * HD + 16 * et + c] = (bf16)f2bf(acc[r]); }
        }
        u32x2v ktr[8]; tr_read8x8(tra + 4096 + 5120, r7, ktr);
#pragma unroll
        for (int d = 0; d < 8; ++d) {
            const u32x2v kt = ktr[d];
            const f32x4 D4 = *(const LAS f32x4*)(bl + 9216 + (16 * d + 4 * g) * 4);
            S[d] = mfma16((u32x4v){kt[0], kt[1], 0u, 0u}, vf, S[d] * D4);
        }
        }
        if (!sample) SEQ_STEP_END(j, nch, PW);
    }
#undef CSEQ_STAGE
#undef CSEQ_STAGE_TO
    {
        if (sample) acc_to_state_store(F, S, F.a->out + O_HSS + sidx * (HD * HD));
        else if (comp) { float* So = F.a->out + (sample ? O_HSS : O_HSP) + sidx * (HD * HD) + 16 * et + c;
#pragma unroll
        for (int d = 0; d < 8; ++d)
#pragma unroll
            for (int r = 0; r < 4; ++r) So[(16 * d + 4 * g + r) * HD] = S[d][r]; }
    }
}
constexpr int BLOB_B = 18432;
constexpr int NSEQ_BP = BATCH * HB, NSEQ_BS = DB * HB;
static_assert(WS_BLOB_B + (size_t)(NSEQ_BP * NCH_P + NSEQ_BS) * BLOB_B <= WS_END, "DeltaNet blobs");
__device__ __forceinline__ void gdn_conv4(const Frame& F, int layer, int sample, int b, size_t seqrow0, int tt, int ch, float (&o)[4]) {
    const bf16* proj = (const bf16*)(F.a->ws + WS_PROJ);
    float a0 = 0.f, a1 = 0.f, a2 = 0.f, a3 = 0.f;
#pragma unroll
    for (int j = 0; j < 4; ++j) { const int tau = tt - 3 + j; float u0, u1, u2, u3;
        if (tau >= 0) { const uint2 w = *(const uint2*)(proj + (seqrow0 + tau) * NP + C_BQ + ch); u0 = bflo(w.x); u1 = bfhi(w.x); u2 = bflo(w.y); u3 = bfhi(w.y); }
        else if (sample) { const f32x4 s = *(const f32x4*)(F.a->in[6] + ((size_t)(layer * DB + b) * 3 + (3 + tau)) * NCONV + ch); u0 = s[0]; u1 = s[1]; u2 = s[2]; u3 = s[3]; }
        else { u0 = 0.f; u1 = 0.f; u2 = 0.f; u3 = 0.f; }
        const f32x4 wv = *(const f32x4*)(F.a->in[14] + ((size_t)layer * 4 + j) * NCONV + ch);
        a0 += wv[0] * u0; a1 += wv[1] * u1; a2 += wv[2] * u2; a3 += wv[3] * u3; }
    o[0] = siluf_(a0); o[1] = siluf_(a1); o[2] = siluf_(a2); o[3] = siluf_(a3);
}
__device__ __forceinline__ u32x4v frag4(const f32x4 x) { return (u32x4v){pk2(x[0], x[1]), pk2(x[2], x[3]), 0u, 0u}; }
template <int SAMPLE>
__device__ __forceinline__ void gdn_conv_op(const Frame& F, int layer, int b, size_t seqrow0, int chunk, int c, int g, int h, const int op, const LAS float* wb, float (&out)[32]) {
    const bf16* proj = (const bf16*)(F.a->ws + WS_PROJ);
    const int chb = op * 768 + h * HD + 4 * g;
#define GDN_TAP(j, SHL, SHR) do { const f32x4 wv = *(const LAS f32x4*)(wb + ((j) * 3 + op) * 128 + 16 * p + 4 * g); f32x4 t; \
            _Pragma("unroll") for (int i = 0; i < 4; ++i) { const float oldv = SAMPLE ? 0.f : ((j) == 0 ? ex[q][i] : DPP_F(ex[q][i], SHL, 0.f, true));     \
                t[i] = DPP_F(mn[q][i], SHR, oldv, false); }                                                                                                  \
            acc += wv * t; } while (0)
#pragma unroll
    for (int hf = 0; hf < 2; ++hf) {
        f32x4 mn[4], ex[4];
        if (!SAMPLE) {
            const bf16* pm = proj + (seqrow0 + chunk * 16 + c) * NP + C_BQ + chb + 64 * hf;
            const bool he = chunk > 0 && c < 3;
            const bf16* pe = proj + (seqrow0 + (he ? chunk * 16 - 3 + c : 0)) * NP + C_BQ + chb + 64 * hf;
#pragma unroll
            for (int q = 0; q < 4; ++q) { const uint2 w = *(const uint2*)(pm + 16 * q); mn[q] = (f32x4){bflo(w.x), bfhi(w.x), bflo(w.y), bfhi(w.y)};
                uint2 e = *(const uint2*)(pe + 16 * q); if (!he) e = make_uint2(0u, 0u); ex[q] = (f32x4){bflo(e.x), bfhi(e.x), bflo(e.y), bfhi(e.y)}; }
        } else {
            const bool tk = c >= 8, st = c >= 5 && c < 8;
            const bf16* pm = proj + (seqrow0 + (tk ? c - 8 : 0)) * NP + C_BQ + chb + 64 * hf;
            const float* ps = F.a->in[6] + ((size_t)(layer * DB + b) * 3 + (st ? c - 5 : 0)) * NCONV + chb + 64 * hf;
#pragma unroll
            for (int q = 0; q < 4; ++q) { const uint2 w = *(const uint2*)(pm + 16 * q); const f32x4 sv = *(const f32x4*)(ps + 16 * q);
                const f32x4 mv = (f32x4){bflo(w.x), bfhi(w.x), bflo(w.y), bfhi(w.y)};
                mn[q] = tk ? mv : (st ? sv : (f32x4){0.f, 0.f, 0.f, 0.f}); ex[q] = (f32x4){0.f, 0.f, 0.f, 0.f}; }
        }
#pragma unroll
        for (int q = 0; q < 4; ++q) { const int p = 4 * hf + q;
            f32x4 acc = *(const LAS f32x4*)(wb + (3 * 3 + op) * 128 + 16 * p + 4 * g) * mn[q];
            GDN_TAP(0, 0x101, 0x113); GDN_TAP(1, 0x101, 0x112); GDN_TAP(2, 0x102, 0x111);
#pragma unroll
            for (int i = 0; i < 4; ++i) out[4 * p + i] = siluf_(acc[i]);
        }
        asm volatile("" ::: "memory");
    }
#undef GDN_TAP
}
template <int SAMPLE>
__device__ __forceinline__ void gdn_pre(const Frame& F, int layer, int b, int h, int chunk, unsigned char* blob) {
    constexpr int sample = SAMPLE;
    int l_ = ((int)threadIdx.x & 63); if (!SAMPLE) asm volatile("" : "+v"(l_));
    const int l = l_, c = l & 15, g = l >> 4;
    LAS unsigned char* scr = F.lds + F.wave * 16384;
    LAS float* wb = (LAS float*)(scr + 8192);
    const float* gates = (const float*)(F.a->ws + WS_GATES);
    size_t row; const bool valid = slot_row(sample, b, chunk, c, row);
    const size_t seqrow0 = sample ? (size_t)(MP_ROWS + b * DS) : (size_t)b * LP;
    const float vm = valid ? 1.f : 0.f;
#pragma unroll
    for (int k = 0; k < 6; ++k) { const int idx = l + 64 * k, j = idx / 96, rem = idx - j * 96, o = rem >> 5, d4 = rem & 31;
        *(LAS f32x4*)(wb + idx * 4) = *(const f32x4*)(F.a->in[14] + ((size_t)layer * 4 + j) * NCONV + o * 768 + h * HD + d4 * 4); }
    const float gval = valid ? -__expf(F.a->in[12][layer * HB + h]) * softplusf_(gates[row * 32 + 12 + h] + F.a->in[13][layer * HB + h]) : 0.f;
    const float beta = valid ? sigmoidf_(gates[row * 32 + 18 + h]) : 0.f;
    const float G = row_cumsum16(gval), G15 = dpp_sum16(gval);
    const float eG = __expf(G), eK = __expf(G15 - G);
    u32x4v kf[4], qf[4];
    {
        float v[32]; gdn_conv_op<SAMPLE>(F, layer, b, seqrow0, chunk, c, g, h, 2, wb, v);
#pragma unroll
        for (int p = 0; p < 8; ++p) { const int d = 16 * p + 4 * g;
            *(LAS u32x2v*)(scr + 4096 + c * 256 + ((d * 2) ^ ((c & 7) << 5))) = (u32x2v){pk2(v[4 * p] * vm, v[4 * p + 1] * vm), pk2(v[4 * p + 2] * vm, v[4 * p + 3] * vm)}; }
    }
    {
        float kv[32]; gdn_conv_op<SAMPLE>(F, layer, b, seqrow0, chunk, c, g, h, 1, wb, kv);
        float ss = 0.f;
#pragma unroll
        for (int i = 0; i < 32; ++i) ss += kv[i] * kv[i];
        ss += __shfl_xor(ss, 16); ss += __shfl_xor(ss, 32);
        const float rk = rsqrtf(ss + 1e-6f) * vm;
        unsigned char* kimg = blob + 9216;
#pragma unroll
        for (int p = 0; p < 8; ++p) { const int kk = p >> 1, hh = p & 1, d = 16 * p + 4 * g;
            const float k0 = kv[4 * p] * rk, k1 = kv[4 * p + 1] * rk, k2 = kv[4 * p + 2] * rk, k3 = kv[4 * p + 3] * rk;
            const unsigned w0 = pk2(k0, k1), w1 = pk2(k2, k3);
            if (hh == 0) { kf[kk][0] = w0; kf[kk][1] = w1; } else { kf[kk][2] = w0; kf[kk][3] = w1; }
            *(LAS u32x2v*)(scr + c * 256 + ((d * 2) ^ ((c & 7) << 5))) = (u32x2v){w0, w1};
            *(uint2*)(kimg + c * 256 + ((d * 2) ^ ((c & 7) << 5))) = make_uint2(pk2(k0 * eK, k1 * eK), pk2(k2 * eK, k3 * eK)); }
    }
    {
        float qv[32]; gdn_conv_op<SAMPLE>(F, layer, b, seqrow0, chunk, c, g, h, 0, wb, qv);
        float ss = 0.f;
#pragma unroll
        for (int i = 0; i < 32; ++i) ss += qv[i] * qv[i];
        ss += __shfl_xor(ss, 16); ss += __shfl_xor(ss, 32);
        const float rq = rsqrtf(ss + 1e-6f) * 0.08838834764831845f * vm, rg = rq * eG;
#pragma unroll
        for (int kk = 0; kk < 4; ++kk) { const int o = 8 * kk;
            qf[kk] = (u32x4v){pk2(qv[o] * rq, qv[o + 1] * rq), pk2(qv[o + 2] * rq, qv[o + 3] * rq), pk2(qv[o + 4] * rq, qv[o + 5] * rq), pk2(qv[o + 6] * rq, qv[o + 7] * rq)};
            *(u32x4v*)(blob + 1024 + kk * 1024 + l * 16) = (u32x4v){pk2(qv[o] * rg, qv[o + 1] * rg), pk2(qv[o + 2] * rg, qv[o + 3] * rg), pk2(qv[o + 4] * rg, qv[o + 5] * rg), pk2(qv[o + 6] * rg, qv[o + 7] * rg)}; }
    }
    const f32x4 z4 = (f32x4){0.f, 0.f, 0.f, 0.f};
    f32x4 KK = z4, KQ = z4;
#pragma unroll
    for (int kk = 0; kk < 4; ++kk) { KK = mfma16(kf[kk], kf[kk], KK); KQ = mfma16(kf[kk], qf[kk], KQ); }
    f32x4 Aqk, LRn, LCn, Id, bs, eGs;
#pragma unroll
    for (int r = 0; r < 4; ++r) { const int s = 4 * g + r; const float Gs = __shfl(G, (l & 48) | s); bs[r] = __shfl(beta, (l & 48) | s);
        eGs[r] = __expf(Gs);
        Aqk[r] = (s <= c) ? __expf(G - Gs) * KQ[r] : 0.f;
        LRn[r] = (s < c) ? beta * __expf(G - Gs) * KK[r] : 0.f;
        LCn[r] = (c < s) ? bs[r] * __expf(Gs - G) * KK[r] : 0.f;
        Id[r] = (s == c) ? 1.f : 0.f; }
    *(u32x4v*)(blob + l * 16) = frag4(Aqk);
    const f32x4 LC2 = mfma16(frag4(LRn), frag4(LCn), z4), LR2 = mfma16(frag4(LCn), frag4(LRn), z4);
    const f32x4 LC4 = mfma16(frag4(LR2), frag4(LC2), z4), LR4 = mfma16(frag4(LC2), frag4(LR2), z4);
    const f32x4 LC8 = mfma16(frag4(LR4), frag4(LC4), z4);
    const f32x4 LRp1 = mfma16(frag4(Id + LC2), frag4(Id - LRn), z4);
    const f32x4 LRp2 = mfma16(frag4(Id + LC4), frag4(LRp1), z4);
    const f32x4 LRt = mfma16(frag4(Id + LC8), frag4(LRp2), z4);
    const u32x4v TU = frag4(LRt * bs), TW = frag4(LRt * bs * eGs);
    const unsigned tra = (unsigned)(size_t)scr + (unsigned)((4 * g + (c >> 2)) * 256 + (c & 3) * 8), r7 = (unsigned)((4 * g + (c >> 2)) & 7);
    u32x2v vtr[8], ktr[8]; tr_read8x8(tra + 4096, r7, vtr); tr_read8x8(tra, r7, ktr);
#pragma unroll
    for (int e = 0; e < 8; ++e) { const u32x2v vt = vtr[e];
        const f32x4 U = mfma16(TU, (u32x4v){vt[0], vt[1], 0u, 0u}, z4);
        *(uint2*)(blob + 13312 + e * 512 + l * 8) = make_uint2(pk2(U[0], U[1]), pk2(U[2], U[3])); }
#pragma unroll
    for (int kk = 0; kk < 4; ++kk) { const u32x2v k0 = ktr[2 * kk], k1 = ktr[2 * kk + 1];
        const f32x4 W0 = mfma16((u32x4v){k0[0], k0[1], 0u, 0u}, TW, z4), W1 = mfma16((u32x4v){k1[0], k1[1], 0u, 0u}, TW, z4);
        *(u32x4v*)(blob + 5120 + kk * 1024 + l * 16) = (u32x4v){pk2(-W0[0], -W0[1]), pk2(-W0[2], -W0[3]), pk2(-W1[0], -W1[1]), pk2(-W1[2], -W1[3])}; }
    if (l == 0) *(float*)(blob + 17408) = __expf(G15);
}
__device__ __forceinline__ void gdn_seq(const Frame& F, int layer, int sample, int b, int h, int half, const Pref pf) {
    const int l = ((int)threadIdx.x & 63), c = l & 15, g = l >> 4, w = F.wave;
    const bool split = half >= 0; const int et = split ? half * 4 + (w & 3) : w; const bool comp = !split || w < 4; const int lw = split ? w - 4 : w, nl = split ? 4 : 8;
    const int nch = sample ? 1 : NCH_P;
    const size_t sidx = (size_t)(layer * (sample ? DB : BATCH) + b) * HB + h;
    const unsigned char* blob0 = F.a->ws + WS_BLOB_B + (size_t)(sample ? NSEQ_BP * NCH_P + b * HB + h : (b * HB + h) * NCH_P) * BLOB_B;
    f32x4 S[8];
#pragma unroll
    for (int d = 0; d < 8; ++d) S[d] = (f32x4){0.f, 0.f, 0.f, 0.f};
#define BSEQ_STAGE_TO(bi_, blobj_) do { LAS unsigned char* bufp_ = F.lds + (bi_) * BLOB_B; \
        _Pragma("unroll") for (int pi_ = 0; pi_ < 5; ++pi_) { const int pc_ = lw + nl * pi_; if (lw >= 0 && pc_ < 18) \
            __builtin_amdgcn_global_load_lds((const unsigned*)((blobj_) + pc_ * 1024 + l * 16), (LAS unsigned*)(bufp_ + pc_ * 1024), 16, 0, 0); } } while (0)
#define BSEQ_STAGE(j) BSEQ_STAGE_TO((j) % SEQ_NB, blob0 + (size_t)(j) * BLOB_B)
    if (sample) {
        if (!pf.pre) { __syncthreads(); state_dma(F, F.a->in[5] + sidx * (HD * HD)); BSEQ_STAGE_TO(pf.par, blob0); }
        wait_vm(0); SEQ_SYNC();
        state_to_acc(F, S);
        SEQ_SYNC();
        if (pf.nxt) { const size_t nidx = (size_t)(layer * DB + pf.nb) * HB + pf.nh;
            state_dma(F, F.a->in[5] + nidx * (HD * HD)); BSEQ_STAGE_TO(pf.par ^ 1, F.a->ws + WS_BLOB_B + (size_t)(NSEQ_BP * NCH_P + pf.nb * HB + pf.nh) * BLOB_B); }
    } else __syncthreads();
    const int PW = lw < 0 ? 0 : (18 - lw + nl - 1) / nl;
    if (!sample) SEQ_PROLOGUE(BSEQ_STAGE, nch, PW);
    for (int j = 0; j < nch; ++j) {
        if (!sample && j + SEQ_D < nch) BSEQ_STAGE(j + SEQ_D);
        if (comp) {
        LAS unsigned char* bl = F.lds + (sample ? pf.par : j % SEQ_NB) * BLOB_B;
        const unsigned tra = (unsigned)(size_t)bl + (unsigned)((4 * g + (c >> 2)) * 256 + (c & 3) * 8), r7 = (unsigned)((4 * g + (c >> 2)) & 7);
        const u32x2v uw = *(const LAS u32x2v*)(bl + 13312 + et * 512 + l * 8);
        f32x4 Wacc = (f32x4){bflo(uw[0]), bfhi(uw[0]), bflo(uw[1]), bfhi(uw[1])}, oacc = (f32x4){0.f, 0.f, 0.f, 0.f};
#pragma unroll
        for (int kk = 0; kk < 4; ++kk) {
            const u32x4v sf = (u32x4v){pk2(S[2 * kk][0], S[2 * kk][1]), pk2(S[2 * kk][2], S[2 * kk][3]), pk2(S[2 * kk + 1][0], S[2 * kk + 1][1]), pk2(S[2 * kk + 1][2], S[2 * kk + 1][3])};
            Wacc = mfma16(*(const LAS u32x4v*)(bl + 5120 + kk * 1024 + l * 16), sf, Wacc);
            oacc = mfma16(*(const LAS u32x4v*)(bl + 1024 + kk * 1024 + l * 16), sf, oacc);
        }
        const u32x4v wf = frag4(Wacc);
        oacc = mfma16(*(const LAS u32x4v*)(bl + l * 16), wf, oacc);
        {
            bf16* hc = (bf16*)(F.a->ws + WS_HCAT);
#pragma unroll
            for (int r = 0; r < 4; ++r) { size_t row; const bool valid = slot_row(sample, b, j, 4 * g + r, row);
                if (valid) hc[row * MIX + 768 + h * HD + 16 * et + c] = (bf16)f2bf(oacc[r]); }
        }
        const float eG15 = *(const LAS float*)(bl + 17408);
        u32x2v ktr[8]; tr_read8x8(tra + 9216, r7, ktr);
#pragma unroll
        for (int d = 0; d < 8; ++d) {
            const u32x2v kt = ktr[d];
            S[d] = mfma16((u32x4v){kt[0], kt[1], 0u, 0u}, wf, S[d] * eG15);
        }
        }
        if (!sample) SEQ_STEP_END(j, nch, PW);
    }
#undef BSEQ_STAGE
#undef BSEQ_STAGE_TO
    {
        if (sample) acc_to_state_store(F, S, F.a->out + O_GSS + sidx * (HD * HD));
        else if (comp) { float* So = F.a->out + (sample ? O_GSS : O_GSP) + sidx * (HD * HD) + 16 * et + c;
#pragma unroll
        for (int d = 0; d < 8; ++d)
#pragma unroll
            for (int r = 0; r < 4; ++r) So[(16 * d + 4 * g + r) * HD] = S[d][r]; }
    }
}
__device__ __forceinline__ void pre_mixers(const Frame& F, int layer) {
    const int gw_ = F.vb * NWAVES + F.wave, nw_ = F.G * NWAVES;
#define PRE_LOOP(off, n, it) int PRE_CAT(o_, __LINE__) = (off); while (PRE_CAT(o_, __LINE__) >= nw_) PRE_CAT(o_, __LINE__) -= nw_;        \
    for (int it = gw_ - PRE_CAT(o_, __LINE__) + (gw_ < PRE_CAT(o_, __LINE__) ? nw_ : 0); it < (n); it += nw_)
#define PRE_CAT(a, b) PRE_CAT2(a, b)
#define PRE_CAT2(a, b) a##b
    constexpr int n0 = NSEQ_BP * NCH_P, n1 = NSEQ_BS, n2 = NSEQ_AP * NCH_P, n3 = NSEQ_AS, n4 = NSEQ_CP * NCH_P, n5 = NSEQ_CS;
    PRE_LOOP(0, n0, it) { const int seq = it / NCH_P, ch = it - seq * NCH_P; gdn_pre<0>(F, layer, seq / HB, seq % HB, ch, F.a->ws + WS_BLOB_B + (size_t)it * BLOB_B); }
    PRE_LOOP(n0, n1, it) gdn_pre<1>(F, layer, it / HB, it % HB, 0, F.a->ws + WS_BLOB_B + (size_t)(NSEQ_BP * NCH_P + it) * BLOB_B);
    PRE_LOOP(n0 + n1, n2, it) { const int seq = it / NCH_P, ch = it - seq * NCH_P; mlstm_pre(F, layer, 0, seq / HA, seq % HA, ch, F.a->ws + WS_BLOB_A + (size_t)it * BLOB_A); }
    PRE_LOOP(n0 + n1 + n2, n3, it) mlstm_pre(F, layer, 1, it / HA, it % HA, 0, F.a->ws + WS_BLOB_A + (size_t)(NSEQ_AP * NCH_P + it) * BLOB_A);
    PRE_LOOP(n0 + n1 + n2 + n3, n4, it) { const int seq = it / NCH_P, ch = it - seq * NCH_P; hgrn_pre(F, layer, 0, seq / HC, seq % HC, ch, F.a->ws + WS_BLOB_C + (size_t)it * BLOB_C); }
    PRE_LOOP(n0 + n1 + n2 + n3 + n4, n5, it) hgrn_pre(F, layer, 1, it / HC, it % HC, 0, F.a->ws + WS_BLOB_C + (size_t)(NSEQ_CP * NCH_P + it) * BLOB_C);
#undef PRE_LOOP
#undef PRE_CAT
#undef PRE_CAT2
}
__device__ __forceinline__ void pc_mixers(const Frame& F, int layer) {
    for (int i = F.vb * 512 + ((int)threadIdx.x); i < (BATCH + DB) * 3 * NCONV; i += F.G * 512) {
        const int ch = i % NCONV, j = (i / NCONV) % 3, bb = i / (3 * NCONV);
        if (bb < BATCH) F.a->out[O_GCP + ((size_t)(layer * BATCH + bb) * 3 + j) * NCONV + ch] = bf2f(((const bf16*)(F.a->ws + WS_PROJ))[((size_t)bb * LP + (LP - 3) + j) * NP + C_BQ + ch]);
        else { const int b = bb - BATCH; F.a->out[O_GCS + ((size_t)(layer * DB + b) * 3 + j) * NCONV + ch] = bf2f(((const bf16*)(F.a->ws + WS_PROJ))[((size_t)MP_ROWS + b * DS + (DS - 3) + j) * NP + C_BQ + ch]); }
    }
#define ITEM_LOOP(base, n, I) int I = F.vb; while (I < (base)) I += F.G; for (I -= (base); I < (n); I += F.G)
    const Pref nopf = {0, 0, 0, 0, 0};
    if (F.vb >= F.G - 3) { __syncthreads(); const int it = (F.vb - (F.G - 3)) * NWAVES + F.wave; if (it < NSEQ_AP) mlstm_nwalk(F, layer, it / HA, it % HA); __syncthreads(); }
    { ITEM_LOOP(0, 48, it) { const int sq = it >> 1; gdn_seq(F, layer, 0, sq / HB, sq % HB, it & 1, nopf); } }
    { ITEM_LOOP(48, 48, it) { const int sq = it >> 1; mlstm_seq(F, layer, 0, sq / HA, sq % HA, it & 1, nopf); } }
    { ITEM_LOOP(96, 32, it) { const int sq = it >> 1; hgrn_seq(F, layer, 0, sq / HC, sq % HC, it & 1, nopf); } }
    {
        gu32* qc = (gu32*)(F.a->ws + WS_CTL) + 8192 + layer * 64;
        volatile LAS int* slot = (volatile LAS int*)(F.lds + LDSCTL_OFF + 16);
        const Pref pf0 = {0, 0, 0, 0, 0};
#define QUEUE_NEXT(kind, I) do { __syncthreads(); if (F.tid == 0) *slot = (int)__hip_atomic_fetch_add(qc + 16 * (kind), 1u, __ATOMIC_RELAXED, __HIP_MEMORY_SCOPE_AGENT); __syncthreads(); I = *slot; } while (0)
        {
            constexpr int nmain = (MPAD / 256) * (NMAIN / 256), ndef = (MPAD / 256) * (NDEF / 256); const int r_ = nmain % F.G, nin_ = r_ ? F.G - r_ : 0;
            pg8::Gemm gd{((bf16*)(F.a->ws + WS_A)), ((bf16*)(F.a->ws + WS_WIN)) + ((size_t)layer * NPG + NMAIN) * DM, MPAD, NDEF, DM};
            pg8::EpiBf16 Ed{((bf16*)(F.a->ws + WS_PROJ)), NP, nullptr, -1, 3, 9, 24};
            int u; QUEUE_NEXT(3, u);
            while (nin_ + u < ndef) { pg8::DefOrder D{nin_ + u, nin_ + u + 1, 1, 0, MPAD / 256}; pg8::gemm_phase<pg8::EpiBf16, pg8::DefOrder, true, true>(F.lds, gd, D, Ed); QUEUE_NEXT(3, u); }
        }
        { int it; QUEUE_NEXT(0, it); while (it < DB * HB) { gdn_seq(F, layer, 1, it / HB, it % HB, -1, pf0); QUEUE_NEXT(0, it); } }
        { int it; QUEUE_NEXT(1, it); while (it < DB * HA) { mlstm_seq(F, layer, 1, it / HA, it % HA, -1, pf0); QUEUE_NEXT(1, it); } }
        { int it; QUEUE_NEXT(2, it); while (it < DB * HC) { hgrn_seq(F, layer, 1, it / HC, it % HC, -1, pf0); QUEUE_NEXT(2, it); } }
#undef QUEUE_NEXT
    }
#undef ITEM_LOOP
}
constexpr int N_PHASES = 13;
__global__ void __launch_bounds__(NWAVES * 64, 2) hymba_fwd(Args args) {
    extern __shared__ __attribute__((aligned(16))) unsigned char lds[];
    Frame F;
    F.lds = (LAS unsigned char*)lds; F.a = &args;
    F.tid = threadIdx.x; F.lane = ((int)threadIdx.x) & 63; F.wave = __builtin_amdgcn_readfirstlane(((int)threadIdx.x) >> 6);
    F.G = gridDim.x; F.vb = blockIdx.x;
    gu32* ctl = (gu32*)(args.ws + WS_CTL);
    volatile LAS unsigned* MISC = (volatile LAS unsigned*)(F.lds + MISC_OFF);
    for (int u = ((int)threadIdx.x); u < (LDS_BYTES - LDSCTL_OFF) / 4; u += NWAVES * 64) ((LAS unsigned*)(F.lds + LDSCTL_OFF))[u] = 0u;
    __syncthreads();
    XcdBarrier bar; bar.bar = (unsigned*)(ctl + CW_BAR); bar.x = 0; bar.st = nullptr;
    const int lo = args.ph_lo, hi = args.ph_hi;
    if (hi - lo > 1) bar = xcd_barrier_post((unsigned*)(ctl + CW_BAR), MISC + 8);
#define IN(k) (lo <= (k) && (k) < hi)
#define SEAM(k) do { if (IN(k) && IN((k) + 1)) xcd_barrier(bar); } while (0)
    if (IN(0)) p0_convert(F, 0, F.vb, F.G, 0, 4480);
#define LAYER(layer) do { constexpr int pb = 1 + 6 * (layer); \
        if ((layer) == 0) { if (IN(pb - 1)) pa_norm(F, 0); SEAM(pb - 1); }        \
        if (IN(pb)) { \
            pg8::Gemm g{((bf16*)(args.ws + WS_A)), ((bf16*)(args.ws + WS_WIN)) + (size_t)(layer) * NPG * DM, MPAD, NMAIN, DM}; pg8::StaticOrder S; S.init(MPAD, NMAIN, F.G, (int)blockIdx.x); \
            pg8::EpiBf16 E{((bf16*)(args.ws + WS_PROJ)), NP, (float*)(args.ws + WS_GATES), 24, 9, 0, 3}; \
            pg8::gemm_phase<pg8::EpiBf16, pg8::StaticOrder, true, true>(F.lds, g, S, E); \
              \
            { constexpr int nmain = (MPAD / 256) * (NMAIN / 256); const int r_ = nmain % F.G, nin_ = r_ ? F.G - r_ : 0; \
              pg8::Gemm gd{((bf16*)(args.ws + WS_A)), ((bf16*)(args.ws + WS_WIN)) + ((size_t)(layer) * NPG + NMAIN) * DM, MPAD, NDEF, DM}; \
              pg8::DefOrder D{0, nin_, nin_, (int)blockIdx.x - r_, MPAD / 256}; pg8::EpiBf16 Ed{((bf16*)(args.ws + WS_PROJ)), NP, nullptr, -1, 3, 9, 24}; \
              pg8::gemm_phase<pg8::EpiBf16, pg8::DefOrder, true, true>(F.lds, gd, D, Ed); } \
        } \
        SEAM(pb); \
        if (IN(pb + 1)) pre_mixers(F, (layer)); \
        SEAM(pb + 1); \
        if (IN(pb + 2)) { if ((layer) == 0 && F.vb >= 128) { p0_convert(F, 0, F.vb - 128, F.G - 128, 4480, 4480 + 1024); __syncthreads(); }     \
            pc_mixers(F, (layer)); } \
        SEAM(pb + 2); \
        if (IN(pb + 3)) pdg_phase(F, (layer));        \
        if ((layer) == 0) SEAM(pb + 4); } while (0)
    LAYER(0);
    LAYER(1);
}

extern "C" void kernel_launch(void* const* d_in, const int* in_sizes, int n_in, void* d_out, int out_size, void* d_ws, size_t ws_size, hipStream_t stream) {
    static int grid = 0;
    if (grid == 0) {
        if (n_in != 19 || (size_t)out_size != O_END || ws_size < WS_END) { fprintf(stderr, "kernel_launch: unexpected sizes: n_in %d out %d ws %zu (need 19, %zu, >= %zu)\n", n_in, out_size, ws_size, (size_t)O_END, (size_t)WS_END); grid = -1; return; }
        int dev = 0, cus = 0, per_cu = 0;
        if (hipGetDevice(&dev) != hipSuccess || hipDeviceGetAttribute(&cus, hipDeviceAttributeMultiprocessorCount, dev) != hipSuccess) { grid = -1; return; }
        if (hipFuncSetAttribute((const void*)hymba_fwd, hipFuncAttributeMaxDynamicSharedMemorySize, LDS_BYTES) != hipSuccess) { fprintf(stderr, "kernel_launch: hipFuncSetAttribute failed\n"); grid = -1; return; }
        if (hipOccupancyMaxActiveBlocksPerMultiprocessor(&per_cu, (const void*)hymba_fwd, NWAVES * 64, LDS_BYTES) != hipSuccess || per_cu < 1)
            fprintf(stderr, "kernel_launch: note: occupancy query reports %d workgroups per CU\n", per_cu);
        (void)hipGetLastError();
        grid = cus;
    }
    if (grid < 0) return;
    if (hipMemsetAsync((char*)d_ws + WS_CTL, 0, CTL_ZERO_BYTES, stream) != hipSuccess) { fprintf(stderr, "kernel_launch: memset failed\n"); return; }
    Args a{};
    for (int i = 0; i < 19; ++i) a.in[i] = (const float*)d_in[i];
    a.out = (float*)d_out; a.ws = (unsigned char*)d_ws;
#if MK_PER_PHASE
    for (int p = 0; p < N_PHASES; ++p) { a.ph_lo = p; a.ph_hi = p + 1; hipLaunchKernelGGL(hymba_fwd, dim3(grid), dim3(NWAVES * 64), LDS_BYTES, stream, a); }
#else
    a.ph_lo = 0; a.ph_hi = N_PHASES;
    hipLaunchKernelGGL(hymba_fwd, dim3(grid), dim3(NWAVES * 64), LDS_BYTES, stream, a);
#endif
    const hipError_t le = hipPeekAtLastError();
    if (le != hipSuccess) fprintf(stderr, "kernel_launch: launch failed: %s\n", hipGetErrorName(le));
}
```

```cpp
#include <hip/hip_runtime.h>
#include <cstdio>
#include <cstdint>

#ifndef MK_PER_PHASE
#define MK_PER_PHASE 0
#endif

namespace pg8 {
#define PG8_LAS __attribute__((address_space(3)))
typedef unsigned short bf16_t;
typedef short bf16x8 __attribute__((ext_vector_type(8)));
typedef float f32x4 __attribute__((ext_vector_type(4)));
typedef unsigned u32x4 __attribute__((ext_vector_type(4)));
constexpr int BM = 256, BK = 64, HALF = 128, HTB = HALF * BK * 2  , STAGE_BYTES = 8 * HTB, NXCD = 8, WGM = 8;

__host__ __device__ __forceinline__ int lds_byte(int r, int c) { const int st = (r >> 4) * 2 + (c >> 5), rr = r & 15, cc = c & 31, ob = rr * 64 + cc * 2; return st * 1024 + (ob ^ (((ob >> 9) & 1) << 5)); }
__host__ __device__ __forceinline__ void stage_rc(int b, int& R, int& C) { const int st = b / 1024, sb = b % 1024, swz = sb ^ (((sb >> 9) & 1) << 5); R = (st >> 1) * 16 + swz / 64; C = (st & 1) * 32 + (swz % 64) / 2; }
__host__ __device__ __forceinline__ int perm32(int rho) { const int n = rho >> 4, i = rho & 15; return 8 * (i >> 2) + 4 * n + (i & 3); }

struct Unit { int pm, pn; };
struct Gemm { const bf16_t* A; const bf16_t* Bt; int M, N, K; };

struct StaticOrder {
    int nM, nN, nwg, G, c;
    __host__ __device__ void init(int M, int N, int G_, int c_) { nM = M / BM; nN = N / BM; nwg = nM * nN; G = G_; c = c_; }
    __host__ __device__ bool next(int i, Unit& u) const {
        const long L = (long)i * G + c; if (L >= nwg) return false;
        int wgid = (int)L; { const int q = nwg / NXCD, r = nwg % NXCD, xcd = wgid % NXCD, off = wgid / NXCD; wgid = (xcd < r ? xcd * (q + 1) : r * (q + 1) + (xcd - r) * q) + off; }
        const int nig = WGM * nN, gid = wgid / nig, fm = gid * WGM, gsz = (nM - fm) < WGM ? (nM - fm) : WGM;
        u.pm = fm + ((wgid % nig) % gsz); u.pn = (wgid % nig) / gsz; return true;
    }
    __device__ __forceinline__ void a_ready(const Unit&) const {}
    __device__ __forceinline__ void done(const Unit&) const {}
};

struct MainDefOrder {
    StaticOrder S; int nm, dpm, dpn;
    __device__ __forceinline__ bool next(int i, Unit& u) const { if (i < nm) return S.next(i, u);
        if (i == nm && dpn >= 0) { u.pm = dpm; u.pn = dpn; return true; }
        return false; }
    __device__ __forceinline__ void a_ready(const Unit&) const {}
    __device__ __forceinline__ void done(const Unit&) const {}
};
struct DefOrder {
    int L0, L1, G, c, nM;
    __device__ __forceinline__ bool next(int i, Unit& u) const { const int L = L0 + i * G + c; if (c < 0 || L >= L1) return false; u.pn = L / nM; u.pm = L - u.pn * nM; return true; }
    __device__ __forceinline__ void a_ready(const Unit&) const {}
    __device__ __forceinline__ void done(const Unit&) const {}
};
typedef __bf16 bf16x2_t __attribute__((ext_vector_type(2)));
typedef float f32x2_t __attribute__((ext_vector_type(2)));
__device__ __forceinline__ unsigned cvt_pk_bf16(float lo, float hi) { const f32x2_t v = {lo, hi}; return __builtin_bit_cast(unsigned, __builtin_convertvector(v, bf16x2_t)); }

struct EpiBf16 {
    static constexpr bool PERM = true, AFTER_DRAIN = false;
    bf16_t* O; int ldc; float* gates; int gate_pn, split, add0, add1;
    __device__ __forceinline__ void operator()(const f32x4 (&acc)[2][2][4][2], const Unit& u, int wr, int wc, int fr, int fq) const {
        const int row0 = u.pm * BM + wr * 64 + fr; const int col0 = (u.pn + (u.pn < split ? add0 : add1)) * BM + wc * 32 + 8 * fq;
        if (u.pn == gate_pn) {
            if (wc == 0 && fq < 3) {
#pragma unroll
                for (int ai = 0; ai < 2; ++ai)
#pragma unroll
                    for (int m = 0; m < 4; ++m) { float* gp = gates + (size_t)(row0 + ai * HALF + m * 16) * 32 + 8 * fq;
                        *(f32x4*)gp = acc[ai][0][m][0]; *(f32x4*)(gp + 4) = acc[ai][0][m][1]; } }
            return; }
#pragma unroll
        for (int ai = 0; ai < 2; ++ai)
#pragma unroll
            for (int m = 0; m < 4; ++m) { bf16_t* rowp = O + (size_t)(row0 + ai * HALF + m * 16) * ldc + col0;
#pragma unroll
                for (int bj = 0; bj < 2; ++bj) { const f32x4 v0 = acc[ai][bj][m][0], v1 = acc[ai][bj][m][1];
                    u32x4 w; w.x = cvt_pk_bf16(v0[0], v0[1]); w.y = cvt_pk_bf16(v0[2], v0[3]); w.z = cvt_pk_bf16(v1[0], v1[1]); w.w = cvt_pk_bf16(v1[2], v1[3]);
                    *(u32x4*)(rowp + bj * HALF) = w; } }
    }
};
struct EpiBf16U {
    static constexpr bool PERM = true, AFTER_DRAIN = false;
    bf16_t* O; int ldc; float* gates; static constexpr int gate_pn = 24;
    __device__ __forceinline__ void operator()(const f32x4 (&acc)[2][2][4][2], const Unit& u, int wr, int wc, int fr, int fq) const {
        const int row0 = u.pm * BM + wr * 64 + fr; const int col0 = (u.pn + (u.pn < 9 ? 0 : u.pn < 24 ? 3 : u.pn < 28 ? -16 : -1)) * BM + wc * 32 + 8 * fq;
        if (u.pn == gate_pn) {
            if (wc == 0 && fq < 3) {
#pragma unroll
                for (int ai = 0; ai < 2; ++ai)
#pragma unroll
                    for (int m = 0; m < 4; ++m) { float* gp = gates + (size_t)(row0 + ai * HALF + m * 16) * 32 + 8 * fq;
                        *(f32x4*)gp = acc[ai][0][m][0]; *(f32x4*)(gp + 4) = acc[ai][0][m][1]; } }
            return; }
#pragma unroll
        for (int ai = 0; ai < 2; ++ai)
#pragma unroll
            for (int m = 0; m < 4; ++m) { bf16_t* rowp = O + (size_t)(row0 + ai * HALF + m * 16) * ldc + col0;
#pragma unroll
                for (int bj = 0; bj < 2; ++bj) { const f32x4 v0 = acc[ai][bj][m][0], v1 = acc[ai][bj][m][1];
                    u32x4 w; w.x = cvt_pk_bf16(v0[0], v0[1]); w.y = cvt_pk_bf16(v0[2], v0[3]); w.z = cvt_pk_bf16(v1[0], v1[1]); w.w = cvt_pk_bf16(v1[2], v1[3]);
                    *(u32x4*)(rowp + bj * HALF) = w; } }
    }
};
struct EpiRes {
    static constexpr bool PERM = true, AFTER_DRAIN = false;
    bf16_t* X; const float* xp; const float* meta; const float* xs; int first; int mrows;
    __device__ __forceinline__ const float* src_row(int r) const {
        if (r >= 8256) return xs + (size_t)(r - 8256) * 2048;
        const int b = r / 2064, t = r - b * 2064;
        return t < 16 ? meta + (size_t)t * 2048 : xp + ((size_t)b * 2048 + (t - 16)) * 2048;
    }
    __device__ __forceinline__ void operator()(const f32x4 (&acc)[2][2][4][2], const Unit& u, int wr, int wc, int fr, int fq) const {
        const int row0 = u.pm * BM + wr * 64 + fr, col0 = u.pn * BM + wc * 32 + 8 * fq;
        const auto xrs = __builtin_amdgcn_make_buffer_rsrc((void*)X, 0, 9472 * 2048 * 2, 0x00020000);
#pragma unroll
        for (int ai = 0; ai < 2; ++ai)
#pragma unroll
            for (int m = 0; m < 4; ++m) { const int row = row0 + ai * HALF + m * 16;
                if (row < mrows) { bf16_t* dp = X + (size_t)row * 2048 + col0;
                    if (first) { const float* sp = src_row(row) + col0;
#pragma unroll
                        for (int bj = 0; bj < 2; ++bj) { const f32x4 v0 = *(const f32x4*)(sp + bj * HALF) + acc[ai][bj][m][0], v1 = *(const f32x4*)(sp + bj * HALF + 4) + acc[ai][bj][m][1];
                            u32x4 w; w.x = cvt_pk_bf16(v0[0], v0[1]); w.y = cvt_pk_bf16(v0[2], v0[3]); w.z = cvt_pk_bf16(v1[0], v1[1]); w.w = cvt_pk_bf16(v1[2], v1[3]);
                            __builtin_amdgcn_raw_buffer_store_b128(w, xrs, (row * 2048 + col0 + bj * HALF) * 2, 0, 16); }
                    } else {
#pragma unroll
                        for (int bj = 0; bj < 2; ++bj) { const u32x4 r = *(const u32x4*)(dp + bj * HALF);
                            const f32x4 v0 = (f32x4){__builtin_bit_cast(float, r.x << 16), __builtin_bit_cast(float, r.x & 0xffff0000u), __builtin_bit_cast(float, r.y << 16), __builtin_bit_cast(float, r.y & 0xffff0000u)} + acc[ai][bj][m][0];
                            const f32x4 v1 = (f32x4){__builtin_bit_cast(float, r.z << 16), __builtin_bit_cast(float, r.z & 0xffff0000u), __builtin_bit_cast(float, r.w << 16), __builtin_bit_cast(float, r.w & 0xffff0000u)} + acc[ai][bj][m][1];
                            u32x4 w; w.x = cvt_pk_bf16(v0[0], v0[1]); w.y = cvt_pk_bf16(v0[2], v0[3]); w.z = cvt_pk_bf16(v1[0], v1[1]); w.w = cvt_pk_bf16(v1[2], v1[3]);
                            __builtin_amdgcn_raw_buffer_store_b128(w, xrs, (row * 2048 + col0 + bj * HALF) * 2, 0, 16); }
                    } } }
    }
};

template <class Epi, class Sched, bool ALIGN_EPI = false, bool SP2 = false, int AUX_A = 0>
__device__ __forceinline__ void gemm_phase(PG8_LAS unsigned char* lds, const Gemm g, const Sched& S, const Epi& E) {
    int tid_ = threadIdx.x; asm volatile("" : "+v"(tid_));
    const int tid = tid_, wid = __builtin_amdgcn_readfirstlane(tid >> 6), lane = tid & 63, wr = wid >> 2, wc = wid & 3, fr = lane & 15, fq = lane >> 4;
    const int K = g.K, nt = K / BK;
    unsigned voffA[2], voffB[2];
#pragma unroll
    for (int i = 0; i < 2; ++i) { int R, C; stage_rc(tid * 16 + i * 8192, R, C); const int Rb = Epi::PERM ? ((R & ~31) + perm32(R & 31)) : R;
        voffA[i] = (unsigned)(R * K + C) * 2u; voffB[i] = (unsigned)(Rb * K + C) * 2u; }
    const size_t kstep = (size_t)(BK * 2);
    const size_t hstep = (size_t)HALF * K * 2;
    const size_t tstep = 2 * hstep;
    const unsigned ldsw = (unsigned)wid * 1024u;
    const int aoff = lds_byte(wr * 64 + fr, fq * 8), boff = lds_byte(wc * 32 + fr, fq * 8);
#define PG8_SA(b, h) (((b) * 2 + (h)) * HTB)
#define PG8_SB(b, h) ((4 + (b) * 2 + (h)) * HTB)
#define PG8_STAGE_X(bufoff, gbase, voff, AUX) do { _Pragma("unroll") for (int _i = 0; _i < 2; ++_i) \
        __builtin_amdgcn_global_load_lds((const unsigned*)((const char*)(gbase) + (voff)[_i]), (PG8_LAS unsigned*)(lds + (bufoff) + ldsw + _i * 8192), 16, 0, AUX); } while (0)
#define PG8_STAGE(bufoff, gbase, voff) PG8_STAGE_X(bufoff, gbase, voff, 0)
#define PG8_LDA(dst, b, h) do { _Pragma("unroll") for (int m = 0; m < 4; ++m) _Pragma("unroll") for (int k = 0; k < 2; ++k) dst[m][k] = *(const PG8_LAS bf16x8*)(lds + PG8_SA(b, h) + aoff + m * 2048 + k * 1024); } while (0)
#define PG8_LDB(dst, b, h) do { _Pragma("unroll") for (int n = 0; n < 2; ++n) _Pragma("unroll") for (int k = 0; k < 2; ++k) dst[n][k] = *(const PG8_LAS bf16x8*)(lds + PG8_SB(b, h) + boff + n * 2048 + k * 1024); } while (0)
#define PG8_MMA(ai, bj, At, Bt) do { __builtin_amdgcn_s_setprio(1); _Pragma("unroll") for (int m = 0; m < 4; ++m) _Pragma("unroll") for (int n = 0; n < 2; ++n) _Pragma("unroll") for (int k = 0; k < 2; ++k) \
        acc[ai][bj][m][n] = __builtin_amdgcn_mfma_f32_16x16x32_bf16(Bt[n][k], At[m][k], acc[ai][bj][m][n], 0, 0, 0); __builtin_amdgcn_s_setprio(0); } while (0)
#define PG8_WAIT_V(n) asm volatile("s_waitcnt vmcnt(" #n ")" ::: "memory")
#define PG8_WAIT_L(n) asm volatile("s_waitcnt lgkmcnt(" #n ")" ::: "memory")
#define PG8_BAR __builtin_amdgcn_s_barrier()
#define PG8_SCHED __builtin_amdgcn_sched_barrier(0)
    Unit cur, nxt; int ui = 0;
    if (!S.next(0, cur)) return;
    f32x4 acc[2][2][4][2];
#pragma unroll
    for (int a = 0; a < 2; ++a)
#pragma unroll
        for (int b = 0; b < 2; ++b)
#pragma unroll
            for (int m = 0; m < 4; ++m)
#pragma unroll
                for (int n = 0; n < 2; ++n) acc[a][b][m][n] = (f32x4){0.f, 0.f, 0.f, 0.f};
    bf16x8 At[4][2], B0[2][2], B1[2][2];
    const char* cA = (const char*)g.A + (size_t)cur.pm * tstep; const char* cB = (const char*)g.Bt + (size_t)cur.pn * tstep;
    S.a_ready(cur);
    if constexpr (SP2) {
        PG8_STAGE(PG8_SB(0, 0), cB, voffB); PG8_STAGE(PG8_SB(0, 1), cB + hstep, voffB); PG8_STAGE_X(PG8_SA(0, 0), cA, voffA, AUX_A); PG8_STAGE_X(PG8_SA(0, 1), cA + hstep, voffA, AUX_A);
        if (wr == 1) PG8_BAR;
        PG8_WAIT_V(2); PG8_BAR;
        PG8_STAGE(PG8_SB(1, 0), cB + kstep, voffB); PG8_STAGE_X(PG8_SA(1, 0), cA + kstep, voffA, AUX_A); PG8_STAGE(PG8_SB(1, 1), cB + hstep + kstep, voffB);
        PG8_WAIT_V(6); PG8_BAR;
    } else {
        PG8_STAGE(PG8_SB(0, 0), cB, voffB); PG8_STAGE_X(PG8_SA(0, 0), cA, voffA, AUX_A); PG8_STAGE(PG8_SB(0, 1), cB + hstep, voffB); PG8_STAGE_X(PG8_SA(0, 1), cA + hstep, voffA, AUX_A);
        if (wr == 1) PG8_BAR;
        PG8_WAIT_V(4); PG8_BAR;
        PG8_STAGE(PG8_SB(1, 0), cB + kstep, voffB); PG8_STAGE_X(PG8_SA(1, 0), cA + kstep, voffA, AUX_A); PG8_STAGE(PG8_SB(1, 1), cB + hstep + kstep, voffB);
        PG8_WAIT_V(6); PG8_BAR;
    }
    for (;;) {
        const bool has_next = S.next(ui + 1, nxt);
        const char* nA = has_next ? (const char*)g.A + (size_t)nxt.pm * tstep : cA; const char* nB = has_next ? (const char*)g.Bt + (size_t)nxt.pn * tstep : cB;
        for (int t = 0; t < nt; t += 2) {
            const bool last = (t == nt - 2);
            const char* a1 = cA + (size_t)(t + 1) * kstep;
            const char* a2 = last ? nA : cA + (size_t)(t + 2) * kstep; const char* b2 = last ? nB : cB + (size_t)(t + 2) * kstep;
            const char* a3 = a2 + kstep; const char* b3 = b2 + kstep;
            if (last && has_next) S.a_ready(nxt);
            if constexpr (SP2) {
            PG8_LDB(B0, 0, 0); PG8_LDB(B1, 0, 1); PG8_SCHED; PG8_LDA(At, 0, 0); PG8_STAGE_X(PG8_SA(1, 1), a1 + hstep, voffA, AUX_A);
            PG8_WAIT_V(8); PG8_WAIT_L(0); PG8_BAR; PG8_MMA(0, 0, At, B0); PG8_MMA(0, 1, At, B1); PG8_BAR; PG8_SCHED;
            PG8_LDA(At, 0, 1); PG8_STAGE(PG8_SB(0, 0), b2, voffB); PG8_STAGE(PG8_SB(0, 1), b2 + hstep, voffB); PG8_STAGE_X(PG8_SA(0, 0), a2, voffA, AUX_A);
            PG8_WAIT_V(8); PG8_WAIT_L(0); PG8_BAR; PG8_MMA(1, 0, At, B0); PG8_MMA(1, 1, At, B1); PG8_BAR; PG8_SCHED;
            PG8_LDB(B0, 1, 0); PG8_LDB(B1, 1, 1); PG8_SCHED; PG8_LDA(At, 1, 0); PG8_STAGE_X(PG8_SA(0, 1), a2 + hstep, voffA, AUX_A);
            PG8_WAIT_V(8); PG8_WAIT_L(0); PG8_BAR; PG8_MMA(0, 0, At, B0); PG8_MMA(0, 1, At, B1); PG8_BAR; PG8_SCHED;
            PG8_LDA(At, 1, 1); PG8_STAGE(PG8_SB(1, 0), b3, voffB); PG8_STAGE(PG8_SB(1, 1), b3 + hstep, voffB); PG8_STAGE_X(PG8_SA(1, 0), a3, voffA, AUX_A);
            PG8_WAIT_V(8); PG8_WAIT_L(0); PG8_BAR; PG8_MMA(1, 0, At, B0); PG8_MMA(1, 1, At, B1); PG8_BAR; PG8_SCHED;
            } else {
            PG8_LDB(B0, 0, 0); PG8_SCHED; PG8_LDA(At, 0, 0); PG8_STAGE_X(PG8_SA(1, 1), a1 + hstep, voffA, AUX_A);
            PG8_WAIT_L(8); PG8_BAR; PG8_WAIT_L(0); PG8_MMA(0, 0, At, B0); PG8_BAR; PG8_SCHED;
            PG8_LDB(B1, 0, 1); PG8_STAGE(PG8_SB(0, 0), b2, voffB);
            PG8_BAR; PG8_WAIT_L(0); PG8_MMA(0, 1, At, B1); PG8_BAR;
            PG8_LDA(At, 0, 1); PG8_STAGE_X(PG8_SA(0, 0), a2, voffA, AUX_A);
            PG8_BAR; PG8_WAIT_L(0); PG8_MMA(1, 0, At, B0); PG8_BAR; PG8_SCHED;
            PG8_STAGE(PG8_SB(0, 1), b2 + hstep, voffB);
            PG8_WAIT_V(6); PG8_BAR; PG8_MMA(1, 1, At, B1); PG8_BAR;
            PG8_LDB(B0, 1, 0); PG8_SCHED; PG8_LDA(At, 1, 0); PG8_STAGE_X(PG8_SA(0, 1), a2 + hstep, voffA, AUX_A);
            PG8_WAIT_L(8); PG8_BAR; PG8_WAIT_L(0); PG8_MMA(0, 0, At, B0); PG8_BAR; PG8_SCHED;
            PG8_LDB(B1, 1, 1); PG8_STAGE(PG8_SB(1, 0), b3, voffB);
            PG8_BAR; PG8_WAIT_L(0); PG8_MMA(0, 1, At, B1); PG8_BAR;
            PG8_LDA(At, 1, 1); PG8_STAGE_X(PG8_SA(1, 0), a3, voffA, AUX_A);
            PG8_BAR; PG8_WAIT_L(0); PG8_MMA(1, 0, At, B0); PG8_BAR; PG8_SCHED;
            PG8_STAGE(PG8_SB(1, 1), b3 + hstep, voffB);
            PG8_WAIT_V(6); PG8_BAR; PG8_MMA(1, 1, At, B1); PG8_BAR;
            }
        }
        if constexpr (ALIGN_EPI) { if (wr == 0) PG8_BAR; }
        if constexpr (!Epi::AFTER_DRAIN) { E(acc, cur, wr, wc, fr, fq); S.done(cur); }
        if (!has_next) break;
#pragma unroll
        for (int a = 0; a < 2; ++a)
#pragma unroll
            for (int b = 0; b < 2; ++b)
#pragma unroll
                for (int m = 0; m < 4; ++m)
#pragma unroll
                    for (int n = 0; n < 2; ++n) acc[a][b][m][n] = (f32x4){0.f, 0.f, 0.f, 0.f};
        cur = nxt; cA = nA; cB = nB; ++ui;
        if constexpr (ALIGN_EPI) { if (wr == 1) PG8_BAR; }
    }
    PG8_WAIT_V(0);
    if constexpr (!ALIGN_EPI) { if (wr == 0) PG8_BAR; }
    PG8_BAR;
    if constexpr (Epi::AFTER_DRAIN) { E.fused(acc, cur, wr, wc, fr, fq, lds, wid, lane); S.done(cur); }
#undef PG8_SA
#undef PG8_SB
#undef PG8_STAGE
#undef PG8_STAGE_X
#undef PG8_LDA
#undef PG8_LDB
#undef PG8_MMA
#undef PG8_WAIT_V
#undef PG8_WAIT_L
#undef PG8_BAR
#undef PG8_SCHED
}
}

constexpr int NWAVES = 8;
constexpr int DM = 2048, BATCH = 4, SEQ = 2048, NMETA = 16, LP = SEQ + NMETA, DEPTH = 2, DB = 128, DS = 8, HD = 128;
constexpr int HA = 6, HB = 6, HC = 4, MIX = 2048, NIN = 8984, NP = 8960, NPG = 9216, NMAIN = 6400, NDEF = NPG - NMAIN, NCONV = 2304;
constexpr int MP_ROWS = BATCH * LP, MS_ROWS = DB * DS, MROWS = MP_ROWS + MS_ROWS, MPAD = 9472;
static_assert(MROWS == 9280 && MPAD % 256 == 0 && MPAD >= MROWS && DEPTH == 2, "shapes");
constexpr int C_AQ = 0, C_AK = 768, C_AV = 1536, C_AO = 2304, C_BQ = 3072, C_BK = 3840, C_BV = 4608, C_CQ = 5376, C_CF = 5888, C_CI = 6400, C_Z = 6912;
constexpr size_t O_YP = 0, O_YS = O_YP + (size_t)BATCH * SEQ * DM, O_MCP = O_YS + (size_t)DB * DS * DM, O_MNP = O_MCP + (size_t)DEPTH * BATCH * HA * HD * HD,
    O_MMP = O_MNP + (size_t)DEPTH * BATCH * HA * HD, O_GSP = O_MMP + (size_t)DEPTH * BATCH * HA, O_GCP = O_GSP + (size_t)DEPTH * BATCH * HB * HD * HD,
    O_HSP = O_GCP + (size_t)DEPTH * BATCH * 3 * NCONV, O_MCS = O_HSP + (size_t)DEPTH * BATCH * HC * HD * HD, O_MNS = O_MCS + (size_t)DEPTH * DB * HA * HD * HD,
    O_MMS = O_MNS + (size_t)DEPTH * DB * HA * HD, O_GSS = O_MMS + (size_t)DEPTH * DB * HA, O_GCS = O_GSS + (size_t)DEPTH * DB * HB * HD * HD,
    O_HSS = O_GCS + (size_t)DEPTH * DB * 3 * NCONV, O_END = O_HSS + (size_t)DEPTH * DB * HC * HD * HD;
static_assert(O_END == 90109488, "output size");
constexpr size_t MiB = 1u << 20;
constexpr size_t WS_CTL = 0, CTL_ZERO_BYTES = 96 * 1024;
constexpr size_t WS_WIN = 2 * MiB;
constexpr size_t WS_WOUT = 74 * MiB;
constexpr size_t WS_GATES = 90 * MiB;
constexpr size_t WS_A = 92 * MiB;
constexpr size_t WS_PROJ = 130 * MiB;
constexpr size_t WS_HCAT = 292 * MiB;
constexpr size_t WS_XRES = 330 * MiB;
constexpr size_t WS_BLOB_C = 403 * MiB;
constexpr size_t WS_BLOB_B = 429 * MiB;
constexpr size_t WS_END = 498 * MiB;
static_assert(WS_WIN + (size_t)2 * NPG * DM * 2 <= WS_WOUT && WS_WOUT + (size_t)2 * DM * MIX * 2 <= WS_GATES && WS_GATES + (size_t)MPAD * 32 * 4 <= WS_A && WS_A + (size_t)MPAD * DM * 2 <= WS_PROJ && WS_PROJ + (size_t)MPAD * NP * 2 <= WS_HCAT && WS_HCAT + (size_t)MROWS * DM * 2 <= WS_XRES && WS_XRES + (size_t)MROWS * DM * 4 <= WS_BLOB_C, "ws map");
constexpr int CW_BAR = 4096;
constexpr int RING_BYTES = 131072, LDSCTL_OFF = RING_BYTES, MISC_OFF = LDSCTL_OFF + 320, LDS_BYTES = 147456;

#define GAS __attribute__((address_space(1)))
#define LAS __attribute__((address_space(3)))
typedef unsigned short bf16;
typedef float f32x4 __attribute__((ext_vector_type(4)));
typedef GAS unsigned gu32;
#define RLX_AGENT __ATOMIC_RELAXED, __HIP_MEMORY_SCOPE_AGENT
__device__ __forceinline__ unsigned f2bf(float f) { unsigned u = __builtin_bit_cast(unsigned, f); return (u + 0x7fffu + ((u >> 16) & 1u)) >> 16; }
typedef __bf16 bf16x2_t __attribute__((ext_vector_type(2)));
typedef float f32x2_t __attribute__((ext_vector_type(2)));
__device__ __forceinline__ unsigned pk2(float lo, float hi) { const f32x2_t v = {lo, hi}; return __builtin_bit_cast(unsigned, __builtin_convertvector(v, bf16x2_t)); }
__device__ __forceinline__ float bf2f(unsigned short b) { return __builtin_bit_cast(float, (unsigned)b << 16); }
__device__ __forceinline__ void ld8(const bf16* p, float (&f)[8]) { const uint4 w = *(const uint4*)p;
    f[0] = __builtin_bit_cast(float, w.x << 16); f[1] = __builtin_bit_cast(float, w.x & 0xffff0000u); f[2] = __builtin_bit_cast(float, w.y << 16); f[3] = __builtin_bit_cast(float, w.y & 0xffff0000u);
    f[4] = __builtin_bit_cast(float, w.z << 16); f[5] = __builtin_bit_cast(float, w.z & 0xffff0000u); f[6] = __builtin_bit_cast(float, w.w << 16); f[7] = __builtin_bit_cast(float, w.w & 0xffff0000u); }
__device__ __forceinline__ float sigmoidf_(float x) { return __builtin_amdgcn_rcpf(1.0f + __expf(-x)); }
__device__ __forceinline__ float siluf_(float x) { return x * __builtin_amdgcn_rcpf(1.0f + __expf(-x)); }
__device__ __forceinline__ float logsigmoidf_(float x) { return fminf(x, 0.f) - log1pf(__expf(-fabsf(x))); }
__device__ __forceinline__ float softplusf_(float x) { return fmaxf(x, 0.f) + log1pf(__expf(-fabsf(x))); }
__device__ __forceinline__ float red16(float x) {
    x += __builtin_bit_cast(float, __builtin_amdgcn_update_dpp(0, __builtin_bit_cast(int, x), 0xB1, 0xF, 0xF, true));
    x += __builtin_bit_cast(float, __builtin_amdgcn_update_dpp(0, __builtin_bit_cast(int, x), 0x4E, 0xF, 0xF, true));
    x += __builtin_bit_cast(float, __builtin_amdgcn_update_dpp(0, __builtin_bit_cast(int, x), 0x141, 0xF, 0xF, true));
    x += __builtin_bit_cast(float, __builtin_amdgcn_update_dpp(0, __builtin_bit_cast(int, x), 0x140, 0xF, 0xF, true));
    return x; }
__device__ __forceinline__ float red32(float x) { x = red16(x); x += __shfl_xor(x, 16); return x; }
__device__ __forceinline__ float red64(float x) { x = red32(x); x += __shfl_xor(x, 32); return x; }

#define XB_TMO      128
#define XB_XCNT(j)  (256  + 64 * (j))
#define XB_XSUB(j)  (1280 + 64 * (j))
#define XB_XGEN(j)  (2304 + 64 * (j))
#define XB_TOP      3328
#define XB_TOPGEN   3392
#define XCD_BAR_WORDS 3456
#define XB_SPIN_CAP (1u << 20)
__device__ __forceinline__ unsigned xb_ld(unsigned* p)              { return __hip_atomic_load(p, __ATOMIC_RELAXED, __HIP_MEMORY_SCOPE_AGENT); }
__device__ __forceinline__ unsigned xb_add(unsigned* p, unsigned v) { return __hip_atomic_fetch_add(p, v, __ATOMIC_RELAXED, __HIP_MEMORY_SCOPE_AGENT); }
__device__ __forceinline__ unsigned xb_xcc_id() { return (unsigned)__builtin_amdgcn_s_getreg((3 << 11) | 20) & 0xFu; }
#define XB_SPIN(cond, bar) do { unsigned _sp = 0; while (cond) { __builtin_amdgcn_s_sleep(1); \
    if ((++_sp & 255u) == 0u) { if (xb_ld(&(bar)[XB_TMO])) break; if (_sp > XB_SPIN_CAP) { atomicAdd(&(bar)[XB_TMO], 1u); break; } } } } while (0)
struct XcdBarrier { unsigned* bar; unsigned x; volatile LAS unsigned* st; };
__device__ __forceinline__ XcdBarrier xcd_barrier_post(unsigned* bar, volatile LAS unsigned* st) {
    XcdBarrier b; b.bar = bar; b.x = xb_xcc_id(); b.st = st;
    if (threadIdx.x == 0) (void)xb_add(&bar[XB_XCNT(b.x)], 1u);
    return b;
}
__device__ __forceinline__ void xcd_barrier_complete(unsigned* bar, unsigned x, unsigned& nloc, unsigned& nx) {
    const unsigned G = gridDim.x * gridDim.y * gridDim.z;
    unsigned sum, cnt, mine, sp = 0u;
    for (;;) {
        sum = 0u; cnt = 0u; mine = 0u;
#pragma unroll
        for (unsigned j = 0; j < 16; ++j) { const unsigned c = xb_ld(&bar[XB_XCNT(j)]); sum += c; cnt += (c > 0u) ? 1u : 0u; mine = (j == x) ? c : mine; }
        if (sum == G) break;
        __builtin_amdgcn_s_sleep(1);
        if ((++sp & 255u) == 0u) { if (xb_ld(&bar[XB_TMO])) break; if (sp > XB_SPIN_CAP) { atomicAdd(&bar[XB_TMO], 1u); break; } }
    }
    nloc = mine > 0u ? mine : 1u; nx = cnt > 0u ? cnt : 1u;
}
__device__ __forceinline__ void xcd_barrier(const XcdBarrier& b) {
    asm volatile("s_waitcnt vmcnt(0)" ::: "memory");
    __syncthreads();
    if (threadIdx.x == 0) {
        unsigned* bar = b.bar;
        __builtin_amdgcn_s_waitcnt(0);
        unsigned nloc = b.st[0], nx = b.st[1];
        if (nloc == 0u) { xcd_barrier_complete(bar, b.x, nloc, nx); b.st[0] = nloc; b.st[1] = nx; }
        const unsigned old = xb_add(&bar[XB_XSUB(b.x)], 1u);
        const unsigned gen = old / nloc;
        if (old + 1u == (gen + 1u) * nloc) {
            __builtin_amdgcn_fence(__ATOMIC_RELEASE, "agent");
            asm volatile("s_waitcnt vmcnt(0)" ::: "memory");
            const unsigned og = xb_add(&bar[XB_TOP], 1u);
            const unsigned tg = og / nx;
            if (og + 1u == (tg + 1u) * nx) xb_add(&bar[XB_TOPGEN], 1u);
            else XB_SPIN(xb_ld(&bar[XB_TOPGEN]) == tg, bar);
            __builtin_amdgcn_fence(__ATOMIC_ACQUIRE, "agent");
            xb_add(&bar[XB_XGEN(b.x)], 1u);
            asm volatile("s_waitcnt vmcnt(0)" ::: "memory");
        } else {
            XB_SPIN(xb_ld(&bar[XB_XGEN(b.x)]) == gen, bar);
            __builtin_amdgcn_fence(__ATOMIC_ACQUIRE, "agent");
            asm volatile("s_waitcnt vmcnt(0)" ::: "memory");
        }
    }
    __syncthreads();
}

struct Args { const float* in[19]; float* out; unsigned char* ws; int ph_lo, ph_hi; };
struct Frame {
    LAS unsigned char* lds; const Args* a;
    int tid, lane, wave, G, vb;
};
__device__ __forceinline__ const float* xrow0(const Frame& F, int r) {
    if (r >= MP_ROWS) return F.a->in[1] + (size_t)(r - MP_ROWS) * DM;
    const int b = r / LP, t = r - b * LP;
    return t < NMETA ? F.a->in[8] + (size_t)t * DM : F.a->in[0] + ((size_t)b * SEQ + (t - NMETA)) * DM;
}

__device__ __forceinline__ void p0_convert(const Frame& F, const int wl, const int vb0, const int nb, const int t_lo, const int t_hi) {
    LAS float* T = (LAS float*)F.lds;
    int tid_ = ((int)threadIdx.x); asm volatile("" : "+v"(tid_)); const int tid = tid_;
    constexpr int TIN = (NP / 64) * (DM / 64), TOUT = (DM / 64) * (MIX / 64), TPL = TIN + TOUT, NT = TPL;
#define P0_TILE(tl_, src_, dst_, ld_, n0_, k0_, sc0_) do { const int l_ = wl; int r_ = (tl_); \
        if (r_ < TIN) { const int nt_ = r_ >> 5, kt_ = r_ & 31; n0_ = nt_ * 64; k0_ = kt_ * 64; sc0_ = n0_ + (n0_ < C_BQ ? 0 : n0_ < C_CQ ? 12 : 24); { const int t_ = n0_ >> 8; n0_ = ((t_ < 9 ? t_ : t_ < 12 ? t_ + 16 : t_ < 27 ? t_ - 3 : t_ + 1) << 8) | (n0_ & 255); } src_ = F.a->in[10] + (size_t)l_ * DM * NIN; ld_ = NIN; dst_ = ((bf16*)(F.a->ws + WS_WIN)) + (size_t)l_ * NPG * DM; } \
        else { r_ -= TIN; const int nt_ = r_ >> 5, kt_ = r_ & 31; n0_ = nt_ * 64; k0_ = kt_ * 64; sc0_ = n0_; src_ = F.a->in[17] + (size_t)l_ * MIX * DM; ld_ = DM; dst_ = ((bf16*)(F.a->ws + WS_WOUT)) + (size_t)l_ * DM * MIX; } } while (0)
    LAS float* T1 = T + 64 * 65;
    float pv[8], pw[8];
#define P0_LOAD(tl_, dstv_) do { if ((tl_) < t_hi) { const float* src_l; bf16* dst_l; int ld_l, n0_l, k0_l, sc0_l; P0_TILE((tl_), src_l, dst_l, ld_l, n0_l, k0_l, sc0_l); (void)dst_l; (void)n0_l; \
        _Pragma("unroll") for (int i = 0; i < 8; ++i) dstv_[i] = src_l[(size_t)(k0_l + (tid >> 6) + 8 * i) * ld_l + sc0_l + (tid & 63)]; } } while (0)
#define P0_STORE(tl_, Tb_) do { if ((tl_) < t_hi) { const float* src_s; bf16* dst_s; int ld_s, n0_s, k0_s, sc0_s; P0_TILE((tl_), src_s, dst_s, ld_s, n0_s, k0_s, sc0_s); (void)src_s; (void)ld_s; (void)sc0_s; \
        const int n = tid >> 3, ks = (tid & 7) * 8; float v[8]; \
        _Pragma("unroll") for (int j = 0; j < 8; ++j) v[j] = Tb_[(ks + j) * 65 + n]; \
        uint4 w; w.x = pk2(v[0], v[1]); w.y = pk2(v[2], v[3]); w.z = pk2(v[4], v[5]); w.w = pk2(v[6], v[7]); \
        *(uint4*)(dst_s + (size_t)(n0_s + n) * 2048 + k0_s + ks) = w; } } while (0)
    P0_LOAD(t_lo + vb0, pv); P0_LOAD(t_lo + vb0 + nb, pw);
    for (int tl = t_lo + vb0; tl < t_hi; tl += 2 * nb) {
        __syncthreads();
#pragma unroll
        for (int i = 0; i < 8; ++i) T[((tid >> 6) + 8 * i) * 65 + (tid & 63)] = pv[i];
        if (tl + nb < t_hi) {
#pragma unroll
            for (int i = 0; i < 8; ++i) T1[((tid >> 6) + 8 * i) * 65 + (tid & 63)] = pw[i]; }
        __syncthreads();
        P0_LOAD(tl + 2 * nb, pv); P0_LOAD(tl + 3 * nb, pw);
        P0_STORE(tl, T); P0_STORE(tl + nb, T1);
    }
#undef P0_LOAD
#undef P0_STORE
#undef P0_TILE
    if (t_lo == 0) for (int i = vb0 * 512 + tid; i < 24 * DM; i += nb * 512) {
        const int k = i & (DM - 1), j = i >> 11, l = wl;
        const int sc = j < 12 ? 3072 + j : 5388 + (j - 12);
        ((bf16*)(F.a->ws + WS_WIN))[((size_t)l * NPG + 6144 + j) * DM + k] = (bf16)f2bf(F.a->in[10][((size_t)l * DM + k) * NIN + sc]);
    }
}
__device__ __forceinline__ void pa_norm(const Frame& F, int layer) {
    const int lane = ((int)threadIdx.x & 63);
    const float* nw = F.a->in[9] + (size_t)layer * DM;
    for (int r = F.vb * NWAVES + F.wave; r < MROWS; r += F.G * NWAVES) {
        const float* x = xrow0(F, r);
        f32x4 v[8]; float ss = 0.f;
#pragma unroll
        for (int i = 0; i < 8; ++i) { v[i] = *(const f32x4*)(x + i * 256 + lane * 4); ss += v[i][0] * v[i][0] + v[i][1] * v[i][1] + v[i][2] * v[i][2] + v[i][3] * v[i][3]; }
        ss = red64(ss);
        const float rs = rsqrtf(ss * (1.0f / DM) + 1e-6f);
#pragma unroll
        for (int i = 0; i < 8; ++i) { const f32x4 w = *(const f32x4*)(nw + i * 256 + lane * 4); v[i] = v[i] * rs * w;
            uint2 o; o.x = pk2(v[i][0], v[i][1]); o.y = pk2(v[i][2], v[i][3]); *(uint2*)(((bf16*)(F.a->ws + WS_A)) + (size_t)r * DM + i * 256 + lane * 4) = o; }
    }
}
typedef unsigned u32x4pd __attribute__((ext_vector_type(4)));
__device__ __forceinline__ void pd_row2(const Frame& F, int layer, int r0) {
    int lane_ = ((int)threadIdx.x & 63); asm volatile("" : "+v"(lane_)); const int lane = lane_;
    const float* ow = F.a->in[16] + (size_t)layer * MIX;
    const bf16* hrow = ((const bf16*)(F.a->ws + WS_HCAT)) + (size_t)r0 * MIX; const bf16* zrow = ((bf16*)(F.a->ws + WS_PROJ)) + (size_t)r0 * NP + C_Z;
    const float* gt = ((const float*)(F.a->ws + WS_GATES)) + (size_t)r0 * 32 + 24;
    const auto ars = __builtin_amdgcn_make_buffer_rsrc((void*)(F.a->ws + WS_A), 0, MPAD * DM * 2, 0x00020000);
    u32x4pd hw[2][4], zz[2][4], aw[2][2]; float rd[2][2]; f32x4 w[4][2];
#pragma unroll
    for (int q = 0; q < 2; ++q) {
#pragma unroll
        for (int i = 0; i < 4; ++i) { const int c = i * 512 + lane * 8; hw[q][i] = *(const u32x4pd*)(hrow + (size_t)q * MIX + c); zz[q][i] = *(const u32x4pd*)(zrow + (size_t)q * NP + c); }
#pragma unroll
        for (int i = 0; i < 2; ++i) { const int c = i * 512 + lane * 8, hd = c >> 7;
            aw[q][i] = *(const u32x4pd*)(zrow + (size_t)q * NP - C_Z + C_AO + c); rd[q][i] = gt[q * 32 + (hd < 6 ? hd : 5)]; } }
#pragma unroll
    for (int i = 0; i < 4; ++i) { w[i][0] = *(const f32x4*)(ow + i * 512 + lane * 8); w[i][1] = *(const f32x4*)(ow + i * 512 + lane * 8 + 4); }
    asm volatile("" ::: "memory");
#pragma unroll
    for (int i = 0; i < 4; ++i) { const int c = i * 512 + lane * 8;
#pragma unroll
        for (int q = 0; q < 2; ++q) {
            float hv[8];
#pragma unroll
            for (int k = 0; k < 4; ++k) { hv[2 * k] = __builtin_bit_cast(float, hw[q][i][k] << 16); hv[2 * k + 1] = __builtin_bit_cast(float, hw[q][i][k] & 0xffff0000u); }
            if (i < 2) { const bool ml = c < 768; const float rdi = ml ? __builtin_amdgcn_rcpf(rd[q][i]) : 1.f;
#pragma unroll
                for (int k = 0; k < 4; ++k) { const unsigned a = aw[q][i][k];
                    const float s0 = rdi * sigmoidf_(__builtin_bit_cast(float, a << 16)), s1 = rdi * sigmoidf_(__builtin_bit_cast(float, a & 0xffff0000u));
                    hv[2 * k] *= ml ? s0 : 1.f; hv[2 * k + 1] *= ml ? s1 : 1.f; } }
            float ss = 0.f;
#pragma unroll
            for (int k = 0; k < 8; ++k) ss += hv[k] * hv[k];
            ss = red16(ss);
            const float rs = rsqrtf(ss * (1.0f / HD) + 1e-6f);
            float ov[8];
#pragma unroll
            for (int k = 0; k < 4; ++k) { const unsigned z = zz[q][i][k];
                ov[2 * k] = hv[2 * k] * rs * w[i][k >> 1][(2 * k) & 3] * siluf_(__builtin_bit_cast(float, z << 16));
                ov[2 * k + 1] = hv[2 * k + 1] * rs * w[i][k >> 1][(2 * k + 1) & 3] * siluf_(__builtin_bit_cast(float, z & 0xffff0000u)); }
            const u32x4pd o = {pk2(ov[0], ov[1]), pk2(ov[2], ov[3]), pk2(ov[4], ov[5]), pk2(ov[6], ov[7])};
            __builtin_amdgcn_raw_buffer_store_b128(o, ars, ((r0 + q) * DM + c) * 2, 0, 16);
        }
    }
}
__device__ __forceinline__ void xnorm_row2(const Frame& F, int layer, int r0) {
    int lane_ = ((int)threadIdx.x & 63); asm volatile("" : "+v"(lane_)); const int lane = lane_;
    const float* nw = layer == 0 ? F.a->in[9] + (size_t)DM : F.a->in[18];
#pragma unroll
    for (int q = 0; q < 2; ++q) { const int r = r0 + q;
        float* dst = nullptr;
        if (layer != 0) { if (r >= MP_ROWS) dst = F.a->out + O_YS + (size_t)(r - MP_ROWS) * DM; else { const int b = r / LP, t = r - b * LP; if (t < NMETA) continue; dst = F.a->out + O_YP + ((size_t)b * SEQ + (t - NMETA)) * DM; } }
        const bf16* x = ((const bf16*)(F.a->ws + WS_XRES)) + (size_t)r * DM;
        f32x4 v[8]; float ss = 0.f;
#pragma unroll
        for (int i = 0; i < 8; ++i) { const unsigned long long a = __hip_atomic_load((const unsigned long long*)(x + i * 256 + lane * 4), __ATOMIC_RELAXED, __HIP_MEMORY_SCOPE_AGENT);
            const unsigned lo = (unsigned)a, hi = (unsigned)(a >> 32);
            v[i] = (f32x4){__builtin_bit_cast(float, lo << 16), __builtin_bit_cast(float, lo & 0xffff0000u), __builtin_bit_cast(float, hi << 16), __builtin_bit_cast(float, hi & 0xffff0000u)};
            ss += v[i][0] * v[i][0] + v[i][1] * v[i][1] + v[i][2] * v[i][2] + v[i][3] * v[i][3]; }
        ss = red64(ss);
        const float rs = rsqrtf(ss * (1.0f / DM) + 1e-6f);
#pragma unroll
        for (int i = 0; i < 8; ++i) { const f32x4 w = *(const f32x4*)(nw + i * 256 + lane * 4); const f32x4 y = v[i] * rs * w;
            if (layer == 0) { uint2 o; o.x = pk2(y[0], y[1]); o.y = pk2(y[2], y[3]); *(uint2*)(((bf16*)(F.a->ws + WS_A)) + (size_t)r * DM + i * 256 + lane * 4) = o; }
            else __builtin_nontemporal_store(y, (f32x4*)(dst + i * 256 + lane * 4)); }
    }
}
constexpr int PDG_PARTS = 16, PDG_NPAN = MPAD / 256, PDG_CTL = 16384, PDG_CTL_LAYER = 2048;
__device__ __forceinline__ void pdg_phase(const Frame& F, int layer) {
    gu32* qb = (gu32*)(F.a->ws + WS_CTL) + PDG_CTL + layer * PDG_CTL_LAYER;
    volatile LAS int* slot = (volatile LAS int*)(F.lds + LDSCTL_OFF + 16);
    const pg8::Gemm g{((bf16*)(F.a->ws + WS_A)), ((bf16*)(F.a->ws + WS_WOUT)) + (size_t)layer * DM * MIX, MPAD, DM, MIX};
    const pg8::EpiRes E{((bf16*)(F.a->ws + WS_XRES)), F.a->in[0], F.a->in[8], F.a->in[1], layer == 0 ? 1 : 0, MROWS};
    constexpr int conv_tiles = 16, n_conv = (4480 + 1024) / conv_tiles;
    int xq = F.vb & 7, tried = 0;
    for (;;) {
        const int np = (PDG_NPAN - xq + 7) >> 3, total = np == 5 ? 112 : 2 * PDG_PARTS + (np - 2) * (PDG_PARTS + 8) + 16;
        __syncthreads(); if (((int)threadIdx.x) == 0) *slot = (int)__hip_atomic_fetch_add(qb + 16 * xq, 1u, __ATOMIC_RELAXED, __HIP_MEMORY_SCOPE_AGENT); __syncthreads();
        const int i = __builtin_amdgcn_readfirstlane(*slot);
        if (i >= total) { if (++tried >= 8) break; xq = (xq + 1) & 7; continue; }
        int pd_k = -1, pd_part = 0, gm_k = -1, gm_n = 0; bool pair = false;
        if (np == 5) {
            if (i < 16) { pd_k = 0; pd_part = i; } else if (i < 32) { pd_k = 4; pd_part = i - 16; }
            else if (i < 40) { pair = true; gm_k = 0; gm_n = i - 32; }
            else if (i < 88) { const int j = i - 40; pd_k = 1 + (j >> 4); pd_part = j & 15; }
            else { const int j = i - 88; gm_k = 1 + (j >> 3); gm_n = j & 7; }
        } else if (i < 2 * PDG_PARTS) { pd_k = i / PDG_PARTS; pd_part = i % PDG_PARTS; }
        else { const int j = i - 2 * PDG_PARTS, q = j / (PDG_PARTS + 8), r = j - q * (PDG_PARTS + 8);
            if (q < np - 2) { if (r < PDG_PARTS) { pd_k = 2 + q; pd_part = r; } else { gm_k = q; gm_n = r - PDG_PARTS; } }
            else { const int k = j - (np - 2) * (PDG_PARTS + 8); gm_k = np - 2 + (k >> 3); gm_n = k & 7; } }
        if (pd_k >= 0) {
            const int panel = xq + 8 * pd_k, r0 = panel * 256 + pd_part * 16 + F.wave * 2;
            if (r0 < MROWS) pd_row2(F, layer, r0);
            asm volatile("s_waitcnt vmcnt(0)" ::: "memory");
            __syncthreads();
            if (((int)threadIdx.x) == 0) (void)__hip_atomic_fetch_add(qb + 256 + 16 * panel, 1u, __ATOMIC_RELAXED, __HIP_MEMORY_SCOPE_AGENT);
        } else {
            const int panel = xq + 8 * gm_k;
            if (((int)threadIdx.x) == 0) { unsigned sp = 0;
                while (__hip_atomic_load(qb + 256 + 16 * panel, __ATOMIC_RELAXED, __HIP_MEMORY_SCOPE_AGENT) < (unsigned)PDG_PARTS) { __builtin_amdgcn_s_sleep(2); if (++sp > (1u << 22)) break; }
                if (pair) while (__hip_atomic_load(qb + 256 + 16 * (panel + 32), __ATOMIC_RELAXED, __HIP_MEMORY_SCOPE_AGENT) < (unsigned)PDG_PARTS) { __builtin_amdgcn_s_sleep(2); if (++sp > (1u << 22)) break; }
            }
            __syncthreads();
            const int L = gm_n * PDG_NPAN + panel;
            const pg8::DefOrder D{L, pair ? L + 33 : L + 1, 32, 0, PDG_NPAN};
            pg8::gemm_phase<pg8::EpiRes, pg8::DefOrder, true, true, 0>(F.lds, g, D, E);
            if (((int)threadIdx.x) == 0) {
                (void)__hip_atomic_fetch_add(qb + 1024 + 16 * panel, 1u, __ATOMIC_RELAXED, __HIP_MEMORY_SCOPE_AGENT);
                if (pair) (void)__hip_atomic_fetch_add(qb + 1024 + 16 * (panel + 32), 1u, __ATOMIC_RELAXED, __HIP_MEMORY_SCOPE_AGENT); }
        }
    }
    if (layer == 0) for (;;) {
        __syncthreads(); if (((int)threadIdx.x) == 0) *slot = (int)__hip_atomic_fetch_add(qb + 128, 1u, __ATOMIC_RELAXED, __HIP_MEMORY_SCOPE_AGENT); __syncthreads();
        const int t = __builtin_amdgcn_readfirstlane(*slot);
        if (t >= n_conv) break;
        p0_convert(F, 1, 0, 1, t * conv_tiles, (t + 1) * conv_tiles);
    }
    for (;;) {
        __syncthreads(); if (((int)threadIdx.x) == 0) *slot = (int)__hip_atomic_fetch_add(qb + 144, 1u, __ATOMIC_RELAXED, __HIP_MEMORY_SCOPE_AGENT); __syncthreads();
        const int t = __builtin_amdgcn_readfirstlane(*slot);
        if (t >= PDG_NPAN * PDG_PARTS) break;
        const int panel = t / PDG_PARTS, r0 = t * 16 + F.wave * 2;
        if (((int)threadIdx.x) == 0) { unsigned sp = 0;
            while (__hip_atomic_load(qb + 1024 + 16 * panel, __ATOMIC_RELAXED, __HIP_MEMORY_SCOPE_AGENT) < 8u) { __builtin_amdgcn_s_sleep(64); if (++sp > (1u << 20)) break; } }
        __syncthreads();
        if (r0 < MROWS) xnorm_row2(F, layer, r0);
    }
}
__device__ __forceinline__ float dpp_sum16(float x) {
    x += __builtin_bit_cast(float, __builtin_amdgcn_update_dpp(0, __builtin_bit_cast(int, x), 0xB1, 0xF, 0xF, true));
    x += __builtin_bit_cast(float, __builtin_amdgcn_update_dpp(0, __builtin_bit_cast(int, x), 0x4E, 0xF, 0xF, true));
    x += __builtin_bit_cast(float, __builtin_amdgcn_update_dpp(0, __builtin_bit_cast(int, x), 0x141, 0xF, 0xF, true));
    x += __builtin_bit_cast(float, __builtin_amdgcn_update_dpp(0, __builtin_bit_cast(int, x), 0x140, 0xF, 0xF, true));
    return x;
}
__device__ __forceinline__ void cvt8(const uint4 w, float (&f)[8]) {
    f[0] = __builtin_bit_cast(float, w.x << 16); f[1] = __builtin_bit_cast(float, w.x & 0xffff0000u); f[2] = __builtin_bit_cast(float, w.y << 16); f[3] = __builtin_bit_cast(float, w.y & 0xffff0000u);
    f[4] = __builtin_bit_cast(float, w.z << 16); f[5] = __builtin_bit_cast(float, w.z & 0xffff0000u); f[6] = __builtin_bit_cast(float, w.w << 16); f[7] = __builtin_bit_cast(float, w.w & 0xffff0000u); }
__device__ __forceinline__ void lds8(const LAS float* p, float (&f)[8]) { const f32x4 a = *(const LAS f32x4*)p, c = *(const LAS f32x4*)(p + 4);
    f[0] = a[0]; f[1] = a[1]; f[2] = a[2]; f[3] = a[3]; f[4] = c[0]; f[5] = c[1]; f[6] = c[2]; f[7] = c[3]; }
constexpr int LQ = 0, LK = 4096, LF = 8192, LV = 12288, LAO = 16384, LOUT = 20480, LSC = 24576;
template <int TY, int EB>
__device__ __forceinline__ void scan_item(const Frame& F, int layer, int sample, int b, int h, int eb) {
    LAS float* L_ = (LAS float*)F.lds;
    constexpr int EW = 32 * EB;
    const int tid = ((int)threadIdx.x), el = tid >> 4, dl = tid & 15, tok = tid >> 4;
    const int L = sample ? DS : LP;
    const size_t row0 = sample ? (size_t)(MP_ROWS + b * DS) : (size_t)b * LP;
    constexpr int NH = TY == 2 ? HC : 6;
    const size_t sidx = (size_t)(layer * (sample ? DB : BATCH) + b) * NH + h;
    const int hcol = (TY == 0 ? 0 : TY == 1 ? 768 : 1536) + h * HD;
    const int qcol = (TY == 0 ? C_AQ : TY == 1 ? C_BQ : C_CQ) + h * HD + dl * 8, kcol = (TY == 0 ? C_AK : TY == 1 ? C_BK : C_CF) + h * HD + dl * 8;
    const int dv = dl & (4 * EB - 1);
    const int vcol = (TY == 0 ? C_AV : TY == 1 ? C_BV : C_CI) + h * HD + eb * 32 + dv * 8;
    const bool hasv = dl * 8 < EW;
    const bf16* proj = (const bf16*)(F.a->ws + WS_PROJ); const float* gates = (const float*)(F.a->ws + WS_GATES);
    float S[EB][8], nst[8]; float m_run = 0.f;
#pragma unroll
    for (int j = 0; j < 8; ++j) { nst[j] = 0.f;
#pragma unroll
        for (int i = 0; i < EB; ++i) S[i][j] = 0.f; }
    if (sample) {
        const float* S0 = (TY == 0 ? F.a->in[2] : TY == 1 ? F.a->in[5] : F.a->in[7]) + sidx * (HD * HD) + eb * 32;
#pragma unroll
        for (int i = 0; i < EB; ++i)
#pragma unroll
            for (int j = 0; j < 8; ++j) S[i][j] = S0[(dl * 8 + j) * HD + el + 32 * i];
        if (TY == 0) {
#pragma unroll
            for (int j = 0; j < 8; ++j) nst[j] = F.a->in[3][sidx * HD + dl * 8 + j];
            m_run = F.a->in[4][sidx]; }
    }
    uint4 rq[TY == 1 ? 4 : 1], rk[TY == 1 ? 4 : 1], rv[TY == 1 ? 4 : 1], ra; float g0 = 0.f, g1 = 0.f;
    ra = make_uint4(0, 0, 0, 0);
#define ISSUE_LOADS(T0) do { const int t_ = (T0) + tok; if (t_ < L) { const bf16* pr_ = proj + (row0 + t_) * NP; const float* gr_ = gates + (row0 + t_) * 32; \
        if (TY == 1) { _Pragma("unroll") for (int j_ = 0; j_ < 4; ++j_) { const int tau_ = t_ - 3 + j_; \
                if (tau_ >= 0) { const bf16* pj_ = proj + (row0 + tau_) * NP; rq[j_] = *(const uint4*)(pj_ + qcol); rk[j_] = *(const uint4*)(pj_ + kcol); rv[j_] = *(const uint4*)(pj_ + vcol); } \
                else { rq[j_] = make_uint4(0, 0, 0, 0); rk[j_] = rq[j_]; rv[j_] = rq[j_]; } } \
            g0 = gr_[12 + h]; g1 = gr_[18 + h]; } \
        else { rq[0] = *(const uint4*)(pr_ + qcol); rk[0] = *(const uint4*)(pr_ + kcol); rv[0] = *(const uint4*)(pr_ + vcol); \
            if (TY == 0) { ra = *(const uint4*)(pr_ + C_AO + h * HD + eb * 32 + dv * 8); g0 = gr_[h]; g1 = gr_[6 + h]; } } } } while (0)
    ISSUE_LOADS(0);
    for (int t0 = 0; t0 < L; t0 += 32) {
        __syncthreads();
        const int nt = (L - t0) < 32 ? (L - t0) : 32;
        {
            const int t = t0 + tok;
            if (t < L) {
                float q8[8], k8[8], f8[8], v8[8];
                if (TY == 0) {
                    cvt8(rq[0], q8); cvt8(rk[0], k8);
#pragma unroll
                    for (int j = 0; j < 8; ++j) k8[j] *= 0.08838834764831845f;
                    cvt8(rv[0], v8);
                    if (hasv) { float a8[8]; cvt8(ra, a8);
#pragma unroll
                        for (int j = 0; j < 8; ++j) L_[LAO + tok * EW + dl * 8 + j] = sigmoidf_(a8[j]); }
                    if (dl == 0) { L_[LSC + tok * 8 + 0] = g0 + F.a->in[11][layer * 12 + h]; L_[LSC + tok * 8 + 1] = logsigmoidf_(g1 + F.a->in[11][layer * 12 + 6 + h]); }
                } else if (TY == 1) {
                    float aq[8], ak[8], av[8];
#pragma unroll
                    for (int i = 0; i < 8; ++i) { aq[i] = 0.f; ak[i] = 0.f; av[i] = 0.f; }
#pragma unroll
                    for (int j = 0; j < 4; ++j) { const int tau = t - 3 + j; float uq[8], uk[8], uv[8];
                        const float* cw = F.a->in[14] + ((size_t)layer * 4 + j) * NCONV + h * HD + dl * 8;
                        if (sample && tau < 0) { const float* cs = F.a->in[6] + ((size_t)(layer * DB + b) * 3 + (3 + tau)) * NCONV + h * HD + dl * 8;
#pragma unroll
                            for (int i = 0; i < 8; ++i) { uq[i] = cs[i]; uk[i] = cs[768 + i]; uv[i] = cs[1536 + eb * 32 + (dv - dl) * 8 + i]; } }
                        else { cvt8(rq[j], uq); cvt8(rk[j], uk); cvt8(rv[j], uv); }
#pragma unroll
                        for (int i = 0; i < 8; ++i) { aq[i] += cw[i] * uq[i]; ak[i] += cw[768 + i] * uk[i]; av[i] += cw[1536 + eb * 32 + (dv - dl) * 8 + i] * uv[i]; } }
                    float sq = 0.f, sk = 0.f;
#pragma unroll
                    for (int i = 0; i < 8; ++i) { q8[i] = siluf_(aq[i]); k8[i] = siluf_(ak[i]); v8[i] = siluf_(av[i]); sq += q8[i] * q8[i]; sk += k8[i] * k8[i]; }
                    sq = dpp_sum16(sq); sk = dpp_sum16(sk);
                    const float rq_ = rsqrtf(sq + 1e-6f) * 0.08838834764831845f, rk_ = rsqrtf(sk + 1e-6f);
#pragma unroll
                    for (int j = 0; j < 8; ++j) { q8[j] *= rq_; k8[j] *= rk_; }
                    if (dl == 0) { const float g = -__expf(F.a->in[12][layer * HB + h]) * softplusf_(g0 + F.a->in[13][layer * HB + h]);
                        L_[LSC + tok * 8 + 0] = __expf(g); L_[LSC + tok * 8 + 1] = sigmoidf_(g1); }
                } else {
                    float c8[8]; cvt8(rq[0], q8); cvt8(rk[0], c8); cvt8(rv[0], v8);
#pragma unroll
                    for (int j = 0; j < 8; ++j) { const int ch = h * HD + dl * 8 + j;
                        const float lb = layer == 0 ? 0.f : 1.0f / (1.0f + __expf(F.a->in[15][ch] - F.a->in[15][512 + ch]));
                        const float sp = 1.0f / (1.0f + __expf(-c8[j])), sn = 1.0f / (1.0f + __expf(c8[j]));
                        f8[j] = lb + (1.0f - lb) * sp; k8[j] = (1.0f - lb) * sn; q8[j] = siluf_(q8[j]); }
                }
                float kq = 0.f;
#pragma unroll
                for (int j = 0; j < 8; ++j) kq += q8[j] * k8[j];
                kq = dpp_sum16(kq);
                if (dl == 0) L_[LSC + tok * 8 + 3] = kq;
#pragma unroll
                for (int j = 0; j < 8; ++j) { L_[LQ + tok * 128 + dl * 8 + j] = TY == 2 ? q8[j] * f8[j] : q8[j]; L_[LK + tok * 128 + dl * 8 + j] = k8[j]; if (TY == 2) L_[LF + tok * 128 + dl * 8 + j] = f8[j]; }
                if (hasv) {
#pragma unroll
                    for (int j = 0; j < 8; ++j) L_[LV + tok * EW + dl * 8 + j] = v8[j]; }
            }
        }
        if (TY == 0) {
            __syncthreads();
            if (F.wave == 0) {
                const int ln = ((int)threadIdx.x & 63); const bool valid = ln < nt;
                const float li = valid ? L_[LSC + (ln & 31) * 8 + 0] : -1e30f, lf = valid ? L_[LSC + (ln & 31) * 8 + 1] : 0.f;
                float Fc = lf;
#pragma unroll
                for (int d = 1; d < 32; d <<= 1) { const float t_ = __shfl_up(Fc, d); if (ln >= d) Fc += t_; }
                float pm = li - Fc;
#pragma unroll
                for (int d = 1; d < 32; d <<= 1) { const float t_ = __shfl_up(pm, d); if (ln >= d) pm = fmaxf(pm, t_); }
                const float mt = Fc + fmaxf(m_run, pm);
                float mprev = __shfl_up(mt, 1); if (ln == 0) mprev = m_run;
                if (valid) { L_[LSC + ln * 8 + 0] = __expf(lf + mprev - mt); L_[LSC + ln * 8 + 1] = __expf(li - mt); L_[LSC + ln * 8 + 2] = __expf(fminf(-mt, 60.f)); }
                m_run = __shfl(mt, nt - 1);
            }
        }
        __syncthreads();
        if (t0 + 32 < L) ISSUE_LOADS(t0 + 32);
        for (int tt = 0; tt < nt; ++tt) {
            float q[8], k[8], v[EB];
            lds8(L_ + LQ + tt * 128 + dl * 8, q); lds8(L_ + LK + tt * 128 + dl * 8, k);
            const f32x4 sc = *(const LAS f32x4*)(L_ + LSC + tt * 8);
#pragma unroll
            for (int i = 0; i < EB; ++i) v[i] = L_[LV + tt * EW + el + 32 * i];
            if (TY == 0) {
                const float fp = sc[0], ip = sc[1], emt = sc[2], kq = sc[3];
                float p[EB], nq = 0.f;
#pragma unroll
                for (int j = 0; j < 8; ++j) nq += nst[j] * q[j];
#pragma unroll
                for (int i = 0; i < EB; ++i) { p[i] = 0.f;
#pragma unroll
                    for (int j = 0; j < 8; ++j) p[i] += S[i][j] * q[j]; }
                nq = dpp_sum16(nq);
#pragma unroll
                for (int i = 0; i < EB; ++i) p[i] = dpp_sum16(p[i]);
                const float den = fp * nq + ip * kq, rden = 1.0f / fmaxf(fabsf(den), emt), ikq = ip * kq;
#pragma unroll
                for (int i = 0; i < EB; ++i) { if (dl == 0) L_[LOUT + tt * EW + el + 32 * i] = (fp * p[i] + ikq * v[i]) * rden; }
#pragma unroll
                for (int j = 0; j < 8; ++j) { const float ik = ip * k[j]; nst[j] = fp * nst[j] + ik;
#pragma unroll
                    for (int i = 0; i < EB; ++i) S[i][j] = fp * S[i][j] + ik * v[i]; }
            } else if (TY == 1) {
                const float a = sc[0], beta = sc[1], kq = sc[3];
                float u[EB], p[EB];
#pragma unroll
                for (int i = 0; i < EB; ++i) { u[i] = 0.f; p[i] = 0.f;
#pragma unroll
                    for (int j = 0; j < 8; ++j) { u[i] += S[i][j] * k[j]; p[i] += S[i][j] * q[j]; } }
#pragma unroll
                for (int i = 0; i < EB; ++i) { u[i] = dpp_sum16(u[i]); p[i] = dpp_sum16(p[i]); }
#pragma unroll
                for (int i = 0; i < EB; ++i) { const float w = v[i] - a * u[i]; if (dl == 0) L_[LOUT + tt * EW + el + 32 * i] = a * p[i] + beta * kq * w; const float bw = beta * w;
#pragma unroll
                    for (int j = 0; j < 8; ++j) S[i][j] = a * S[i][j] + k[j] * bw; }
            } else {
                const float kq = sc[3];
                float f[8]; lds8(L_ + LF + tt * 128 + dl * 8, f);
                float p[EB];
#pragma unroll
                for (int i = 0; i < EB; ++i) { p[i] = 0.f;
#pragma unroll
                    for (int j = 0; j < 8; ++j) p[i] += S[i][j] * q[j]; }
#pragma unroll
                for (int i = 0; i < EB; ++i) p[i] = dpp_sum16(p[i]);
#pragma unroll
                for (int i = 0; i < EB; ++i) { if (dl == 0) L_[LOUT + tt * EW + el + 32 * i] = p[i] + kq * v[i];
#pragma unroll
                    for (int j = 0; j < 8; ++j) S[i][j] = f[j] * S[i][j] + k[j] * v[i]; }
            }
        }
        __syncthreads();
        { bf16* hc = (bf16*)(F.a->ws + WS_HCAT) + (row0 + t0) * MIX + hcol + eb * 32;
          for (int idx = tid; idx < nt * EW; idx += NWAVES * 64) { const int tt = idx / EW, c = idx - tt * EW;
              float o = L_[LOUT + idx]; if (TY == 0) o *= L_[LAO + idx];
              hc[(size_t)tt * MIX + c] = (bf16)f2bf(o); } }
    }
#undef ISSUE_LOADS
    {
        float* So = F.a->out + (sample ? (TY == 0 ? O_MCS : TY == 1 ? O_GSS : O_HSS) : (TY == 0 ? O_MCP : TY == 1 ? O_GSP : O_HSP)) + sidx * (HD * HD) + eb * 32;
#pragma unroll
        for (int i = 0; i < EB; ++i)
#pragma unroll
            for (int j = 0; j < 8; ++j) So[(dl * 8 + j) * HD + el + 32 * i] = S[i][j];
        if (TY == 0 && eb == 0) {
            if (el == 0) { float* no = F.a->out + (sample ? O_MNS : O_MNP) + sidx * HD;
#pragma unroll
                for (int j = 0; j < 8; ++j) no[dl * 8 + j] = nst[j]; }
            if (tid == 0) F.a->out[(sample ? O_MMS : O_MMP) + sidx] = m_run;
        }
    }
}
typedef short bf16x8 __attribute__((ext_vector_type(8)));
typedef unsigned u32x4v __attribute__((ext_vector_type(4)));
typedef unsigned u32x2v __attribute__((ext_vector_type(2)));
__device__ __forceinline__ f32x4 mfma16(const u32x4v a, const u32x4v b, const f32x4 c) { return __builtin_amdgcn_mfma_f32_16x16x32_bf16(__builtin_bit_cast(bf16x8, a), __builtin_bit_cast(bf16x8, b), c, 0, 0, 0); }
__device__ __forceinline__ u32x2v tr_read8(unsigned lds_addr) { u32x2v r; asm volatile("ds_read_b64_tr_b16 %0, %1\n\ts_waitcnt lgkmcnt(0)" : "=&v"(r) : "v"(lds_addr) : "memory"); return r; }
__device__ __forceinline__ void tr_read8x8(unsigned a0, unsigned r7, u32x2v (&r)[8]) {
    const unsigned x = a0 ^ (r7 << 5);
    asm volatile("ds_read_b64_tr_b16 %0, %8\n\tds_read_b64_tr_b16 %1, %9\n\tds_read_b64_tr_b16 %2, %10\n\tds_read_b64_tr_b16 %3, %11\n\t"
                 "ds_read_b64_tr_b16 %4, %12\n\tds_read_b64_tr_b16 %5, %13\n\tds_read_b64_tr_b16 %6, %14\n\tds_read_b64_tr_b16 %7, %15\n\ts_waitcnt lgkmcnt(0)"
                 : "=&v"(r[0]), "=&v"(r[1]), "=&v"(r[2]), "=&v"(r[3]), "=&v"(r[4]), "=&v"(r[5]), "=&v"(r[6]), "=&v"(r[7])
                 : "v"(x), "v"(x ^ 32u), "v"(x ^ 64u), "v"(x ^ 96u), "v"(x ^ 128u), "v"(x ^ 160u), "v"(x ^ 192u), "v"(x ^ 224u) : "memory"); }
#define DPP_F(x, ctrl, oldv, bc) __builtin_bit_cast(float, __builtin_amdgcn_update_dpp(__builtin_bit_cast(int, (float)(oldv)), __builtin_bit_cast(int, (float)(x)), (ctrl), 0xF, 0xF, (bc)))
__device__ __forceinline__ float row_cumsum16(float x) { x += DPP_F(x, 0x111, 0.f, true); x += DPP_F(x, 0x112, 0.f, true); x += DPP_F(x, 0x114, 0.f, true); x += DPP_F(x, 0x118, 0.f, true); return x; }
__device__ __forceinline__ float row_cummax16(float x) { x = fmaxf(x, DPP_F(x, 0x111, -3.0e38f, false)); x = fmaxf(x, DPP_F(x, 0x112, -3.0e38f, false)); x = fmaxf(x, DPP_F(x, 0x114, -3.0e38f, false)); x = fmaxf(x, DPP_F(x, 0x118, -3.0e38f, false)); return x; }
__device__ __forceinline__ float bflo(unsigned w) { return __builtin_bit_cast(float, w << 16); }
__device__ __forceinline__ float bfhi(unsigned w) { return __builtin_bit_cast(float, w & 0xffff0000u); }
__device__ __forceinline__ void wait_vm(int n) {
    if (n >= 10) asm volatile("s_waitcnt vmcnt(10)" ::: "memory");
    else if (n >= 8) asm volatile("s_waitcnt vmcnt(8)" ::: "memory");
    else if (n >= 6) asm volatile("s_waitcnt vmcnt(6)" ::: "memory");
    else if (n >= 4) asm volatile("s_waitcnt vmcnt(4)" ::: "memory");
    else if (n >= 3) asm volatile("s_waitcnt vmcnt(3)" ::: "memory");
    else if (n >= 2) asm volatile("s_waitcnt vmcnt(2)" ::: "memory");
    else if (n >= 1) asm volatile("s_waitcnt vmcnt(1)" ::: "memory");
    else asm volatile("s_waitcnt vmcnt(0)" ::: "memory");
}
#define SEQ_NB 4
#define SEQ_D 3
#define SEQ_STEP_END(j, nch, PW) do { if ((PW) > 0 && (j) + 1 < (nch)) { const int last_ = ((j) + SEQ_D < (nch) - 1) ? (j) + SEQ_D : (nch) - 1; wait_vm((PW) * (last_ - ((j) + 1))); } \
        asm volatile("s_waitcnt lgkmcnt(0)" ::: "memory"); __builtin_amdgcn_s_barrier(); asm volatile("" ::: "memory"); } while (0)
#define SEQ_PROLOGUE(STAGE, nch, PW) do { _Pragma("unroll") for (int j0_ = 0; j0_ < SEQ_D; ++j0_) if (j0_ < (nch)) STAGE(j0_); \
        if ((PW) > 0) { const int last_ = (SEQ_D - 1 < (nch) - 1) ? SEQ_D - 1 : (nch) - 1; wait_vm((PW) * last_); } \
        asm volatile("s_waitcnt lgkmcnt(0)" ::: "memory"); __builtin_amdgcn_s_barrier(); asm volatile("" ::: "memory"); } while (0)
constexpr int NCH_P = LP / 16;
#define WS_BLOB_A (WS_WIN + (size_t)layer * NPG * DM * 2)
constexpr int BLOB_A = 6144;
constexpr int NSEQ_AP = BATCH * HA, NSEQ_AS = DB * HA;
static_assert((size_t)(NSEQ_AP * NCH_P + NSEQ_AS) * BLOB_A <= (size_t)NMAIN * DM * 2, "mLSTM blobs fit the dead part of the weight copy");
__device__ __forceinline__ bool slot_row(int sample, int b, int chunk, int slot, size_t& row) {
    if (!sample) { row = (size_t)b * LP + chunk * 16 + slot; return true; }
    row = (size_t)MP_ROWS + b * DS + (slot >= 8 ? slot - 8 : 0); return slot >= 8;
}
constexpr int SB_OFF = 40960;
struct Pref { int pre, nxt, nb, nh, par; };
__device__ __forceinline__ void state_dma(const Frame& F, const float* src) {
#pragma unroll
    for (int i = 0; i < 8; ++i) { const int pc = F.wave * 8 + i, ln = ((int)threadIdx.x & 63), row = 2 * pc + (ln >> 5);
        __builtin_amdgcn_global_load_lds((const unsigned*)((const unsigned char*)src + row * 512 + (((ln & 31) ^ (((row >> 2) & 3) << 2)) << 4)), (LAS unsigned*)(F.lds + SB_OFF + pc * 1024), 16, 0, 2); }
}
__device__ __forceinline__ void state_to_acc(const Frame& F, f32x4 (&S)[8]) {
    const int c = ((int)threadIdx.x & 63) & 15, g = ((int)threadIdx.x & 63) >> 4;
    const LAS float* sb = (const LAS float*)(F.lds + SB_OFF) + 16 * (F.wave ^ g) + c;
#pragma unroll
    for (int d = 0; d < 8; ++d)
#pragma unroll
        for (int r = 0; r < 4; ++r) S[d][r] = sb[(16 * d + 4 * g + r) * HD];
}
#define SEQ_SYNC() do { asm volatile("s_waitcnt lgkmcnt(0)" ::: "memory"); __builtin_amdgcn_s_barrier(); asm volatile("" ::: "memory"); } while (0)
__device__ __forceinline__ void acc_to_state_store(const Frame& F, const f32x4 (&S)[8], float* dst) {
    const int c = ((int)threadIdx.x & 63) & 15, g = ((int)threadIdx.x & 63) >> 4;
    LAS float* sb = (LAS float*)(F.lds + SB_OFF) + 16 * (F.wave ^ g) + c;
#pragma unroll
    for (int d = 0; d < 8; ++d)
#pragma unroll
        for (int r = 0; r < 4; ++r) sb[(16 * d + 4 * g + r) * HD] = S[d][r];
    SEQ_SYNC();
#pragma unroll
    for (int i = 0; i < 8; ++i) { const int pc = F.wave * 8 + i, ln = ((int)threadIdx.x & 63), row = 2 * pc + (ln >> 5);
        __builtin_nontemporal_store(*(const LAS u32x4v*)(F.lds + SB_OFF + pc * 1024 + ln * 16), (u32x4v*)((unsigned char*)dst + row * 512 + (((ln & 31) ^ (((row >> 2) & 3) << 2)) << 4))); }
}
__device__ __forceinline__ void mlstm_pre(const Frame& F, int layer, int sample, int b, int h, int chunk, unsigned char* blob) {
    const int l = ((int)threadIdx.x & 63), c = l & 15, g = l >> 4;
    const bf16* proj = (const bf16*)(F.a->ws + WS_PROJ); const float* gates = (const float*)(F.a->ws + WS_GATES);
    size_t row; const bool valid = slot_row(sample, b, chunk, c, row);
    const float li = valid ? gates[row * 32 + h] + F.a->in[11][layer * 12 + h] : -1e30f;
    const float lf = valid ? logsigmoidf_(gates[row * 32 + 6 + h] + F.a->in[11][layer * 12 + 6 + h]) : 0.f;
    const float Fc = row_cumsum16(lf), gv = li - Fc, R = row_cummax16(gv);
    u32x4v qf[4], kf[4];
    const bf16* qp = proj + row * NP + C_AQ + h * HD + 4 * g; const bf16* kp = proj + row * NP + C_AK + h * HD + 4 * g;
#pragma unroll
    for (int kk = 0; kk < 4; ++kk) { const uint2 q0 = *(const uint2*)(qp + 32 * kk), q1 = *(const uint2*)(qp + 32 * kk + 16), k0 = *(const uint2*)(kp + 32 * kk), k1 = *(const uint2*)(kp + 32 * kk + 16);
        qf[kk] = (u32x4v){q0.x, q0.y, q1.x, q1.y}; kf[kk] = (u32x4v){k0.x, k0.y, k1.x, k1.y}; }
    f32x4 st = (f32x4){0.f, 0.f, 0.f, 0.f};
#pragma unroll
    for (int kk = 0; kk < 4; ++kk) st = mfma16(kf[kk], qf[kk], st);
    const float scale = 0.08838834764831845f;
    float P[4]; float rs = 0.f;
#pragma unroll
    for (int r = 0; r < 4; ++r) { const int s = 4 * g + r; const float gs = __shfl(gv, (l & 48) | s);
        P[r] = (s <= c) ? __expf(gs - R) * st[r] * scale : 0.f; rs += P[r]; }
    rs += __shfl_xor(rs, 16); rs += __shfl_xor(rs, 32);
    *(u32x4v*)(blob + l * 16) = (u32x4v){pk2(P[0], P[1]), pk2(P[2], P[3]), 0u, 0u};
    const float R15 = __shfl(R, (l & 48) | 15);
    const float wK = valid ? __expf(gv - R15) * scale : 0.f;
    unsigned char* kimg = blob + 1024; float* dn = (float*)(blob + 5120);
#pragma unroll
    for (int kk = 0; kk < 4; ++kk)
#pragma unroll
        for (int hh = 0; hh < 2; ++hh) { const unsigned w0 = hh ? kf[kk][2] : kf[kk][0], w1 = hh ? kf[kk][3] : kf[kk][1];
            const float v0 = bflo(w0) * wK, v1 = bfhi(w0) * wK, v2 = bflo(w1) * wK, v3 = bfhi(w1) * wK;
            const int d = 32 * kk + 16 * hh + 4 * g;
            *(uint2*)(kimg + c * 256 + ((d * 2) ^ ((c & 7) << 5))) = make_uint2(pk2(v0, v1), pk2(v2, v3));
            const float s0 = dpp_sum16(v0), s1 = dpp_sum16(v1), s2 = dpp_sum16(v2), s3 = dpp_sum16(v3);
            if (c == 0) *(f32x4*)(dn + d) = (f32x4){s0, s1, s2, s3}; }
    if (g == 0) { float* sc = (float*)(blob + 5632); sc[c] = R; sc[16 + c] = Fc; sc[32 + c] = rs; }
}
constexpr int SQ_BUF = 14336;
__device__ __forceinline__ void mlstm_seq(const Frame& F, int layer, int sample, int b, int h, int half, const Pref pf) {
    const int l = ((int)threadIdx.x & 63), c = l & 15, g = l >> 4, w = F.wave;
    const bool split = half >= 0; const int et = split ? half * 4 + (w & 3) : w; const bool comp = !split || w < 4; const int lw = split ? w - 4 : w, nl = split ? 4 : 8;
    const bf16* proj = (const bf16*)(F.a->ws + WS_PROJ);
    const int nch = sample ? 1 : NCH_P;
    const size_t sidx = (size_t)(layer * (sample ? DB : BATCH) + b) * HA + h;
    const unsigned char* blob0 = F.a->ws + WS_BLOB_A + (size_t)(sample ? NSEQ_AP * NCH_P + b * HA + h : (b * HA + h) * NCH_P) * BLOB_A;
    f32x4 C[8], nrep[8]; float m = 0.f;
#pragma unroll
    for (int d = 0; d < 8; ++d) { C[d] = (f32x4){0.f, 0.f, 0.f, 0.f}; nrep[d] = C[d]; }
#define MSEQ_STAGE_TO(bi_, sb_, sh_, j, blobj_) do { LAS unsigned char* bufp_ = F.lds + (bi_) * SQ_BUF; \
        _Pragma("unroll") for (int pi_ = 0; pi_ < 4; ++pi_) { const int pc_ = lw + nl * pi_; if (lw >= 0 && pc_ < 14) { const unsigned char* src_; \
            if (pc_ < 8) { const int im_ = pc_ >> 2, slot_ = 4 * (pc_ & 3) + g; size_t row_; (void)slot_row(sample, (sb_), (j), slot_, row_); \
                src_ = (const unsigned char*)(proj + row_ * NP + (im_ == 0 ? C_AQ : C_AV) + (sh_) * HD + (c ^ ((slot_ & 7) << 1)) * 8); } \
            else src_ = (blobj_) + (pc_ - 8) * 1024 + l * 16; \
            __builtin_amdgcn_global_load_lds((const unsigned*)src_, (LAS unsigned*)(bufp_ + pc_ * 1024), 16, 0, 0); } } } while (0)
#define MSEQ_STAGE(j) MSEQ_STAGE_TO((j) % SEQ_NB, b, h, (j), blob0 + (size_t)(j) * BLOB_A)
    if (sample) {
        const float* n0 = F.a->in[3] + sidx * HD;
#pragma unroll
        for (int d = 0; d < 8; ++d) nrep[d] = *(const f32x4*)(n0 + 16 * d + 4 * g);
        m = F.a->in[4][sidx];
        if (!pf.pre) { __syncthreads(); state_dma(F, F.a->in[2] + sidx * (HD * HD)); MSEQ_STAGE_TO(pf.par, b, h, 0, blob0); }
        wait_vm(0); SEQ_SYNC();
        state_to_acc(F, C);
        SEQ_SYNC();
        if (pf.nxt) { const size_t nidx = (size_t)(layer * DB + pf.nb) * HA + pf.nh;
            state_dma(F, F.a->in[2] + nidx * (HD * HD)); MSEQ_STAGE_TO(pf.par ^ 1, pf.nb, pf.nh, 0, F.a->ws + WS_BLOB_A + (size_t)(NSEQ_AP * NCH_P + pf.nb * HA + pf.nh) * BLOB_A); }
    } else __syncthreads();
    const int PW = lw < 0 ? 0 : (14 - lw + nl - 1) / nl;
    const bool nwave = !split && w == 0;
    if (!sample) SEQ_PROLOGUE(MSEQ_STAGE, nch, PW);
    for (int j = 0; j < nch; ++j) {
        if (!sample && j + SEQ_D < nch) MSEQ_STAGE(j + SEQ_D);
        if (comp || nwave) {
        LAS unsigned char* buf = F.lds + (sample ? pf.par : j % SEQ_NB) * SQ_BUF;
        const unsigned bufa = (unsigned)(size_t)buf;
        LAS unsigned char* bl = buf + 8192;
        const f32x4 R4 = *(const LAS f32x4*)(bl + 5632 + 16 * g), F4 = *(const LAS f32x4*)(bl + 5696 + 16 * g), rs4 = *(const LAS f32x4*)(bl + 5760 + 16 * g);
        const float R15 = *(const LAS float*)(bl + 5632 + 60), F15 = *(const LAS float*)(bl + 5696 + 60);
        const float M15 = fmaxf(m, R15), e15 = __expf(-fabsf(m - R15)), aC = m >= R15 ? 1.f : e15, aD = m >= R15 ? e15 : 1.f;
        f32x4 c1v, c2v;
#pragma unroll
        for (int r = 0; r < 4; ++r) { const float e = __expf(-fabsf(m - R4[r])); const bool ge = m >= R4[r]; c1v[r] = ge ? 1.f : e; c2v[r] = ge ? e : 1.f; }
        if (nwave) {
            f32x4 accn = (f32x4){0.f, 0.f, 0.f, 0.f};
#pragma unroll
            for (int kk = 0; kk < 4; ++kk) {
                const u32x2v q0 = *(const LAS u32x2v*)(buf + c * 256 + ((64 * kk + 8 * g) ^ ((c & 7) << 5))), q1 = *(const LAS u32x2v*)(buf + c * 256 + ((64 * kk + 32 + 8 * g) ^ ((c & 7) << 5)));
                const u32x4v nf = (u32x4v){pk2(nrep[2 * kk][0], nrep[2 * kk][1]), pk2(nrep[2 * kk][2], nrep[2 * kk][3]), pk2(nrep[2 * kk + 1][0], nrep[2 * kk + 1][1]), pk2(nrep[2 * kk + 1][2], nrep[2 * kk + 1][3])};
                accn = mfma16((u32x4v){q0[0], q0[1], q1[0], q1[1]}, nf, accn);
            }
            float* dn_out = (float*)(F.a->ws + WS_GATES) + 24 + h;
#pragma unroll
            for (int r = 0; r < 4; ++r) { const float Mt = fmaxf(m, R4[r]), emt = __expf(fminf(-(F4[r] + Mt), 60.f)), den = c1v[r] * accn[r] + c2v[r] * rs4[r];
                size_t row; const bool valid = slot_row(sample, b, j, 4 * g + r, row);
                if (valid && c == 0) dn_out[row * 32] = fmaxf(fabsf(den), emt); }
#pragma unroll
            for (int d = 0; d < 8; ++d) { const f32x4 dn4 = *(const LAS f32x4*)(bl + 5120 + (16 * d + 4 * g) * 4); nrep[d] = nrep[d] * aC + dn4 * aD; }
        }
        if (comp) {
        f32x4 acc1 = (f32x4){0.f, 0.f, 0.f, 0.f}, acc2 = acc1;
#pragma unroll
        for (int kk = 0; kk < 4; ++kk) {
            const u32x2v q0 = *(const LAS u32x2v*)(buf + c * 256 + ((64 * kk + 8 * g) ^ ((c & 7) << 5))), q1 = *(const LAS u32x2v*)(buf + c * 256 + ((64 * kk + 32 + 8 * g) ^ ((c & 7) << 5)));
            const u32x4v qf = (u32x4v){q0[0], q0[1], q1[0], q1[1]};
            const u32x4v cf = (u32x4v){pk2(C[2 * kk][0], C[2 * kk][1]), pk2(C[2 * kk][2], C[2 * kk][3]), pk2(C[2 * kk + 1][0], C[2 * kk + 1][1]), pk2(C[2 * kk + 1][2], C[2 * kk + 1][3])};
            acc1 = mfma16(cf, qf, acc1);
        }
        const unsigned tra = bufa + (unsigned)((4 * g + (c >> 2)) * 256 + (c & 3) * 8), r7 = (unsigned)((4 * g + (c >> 2)) & 7);
        const u32x2v vt = tr_read8(tra + 4096 + 32 * ((unsigned)et ^ r7));
        const u32x4v vf = (u32x4v){vt[0], vt[1], 0u, 0u};
        const u32x4v pf = *(const LAS u32x4v*)(bl + l * 16);
        acc2 = mfma16(vf, pf, acc2);
        {
            bf16* hc = (bf16*)(F.a->ws + WS_HCAT);
            { const float Rc = *(const LAS float*)(bl + 5632 + 4 * c), ec = __expf(-fabsf(m - Rc)), c1 = m >= Rc ? 1.f : ec, c2 = m >= Rc ? ec : 1.f;
                size_t row; const bool valid = slot_row(sample, b, j, c, row);
                if (valid) *(uint2*)(hc + row * MIX + h * HD + 16 * et + 4 * g) = make_uint2(pk2(c1 * acc1[0] + c2 * acc2[0], c1 * acc1[1] + c2 * acc2[1]), pk2(c1 * acc1[2] + c2 * acc2[2], c1 * acc1[3] + c2 * acc2[3])); }
        }
        u32x2v ktr[8]; tr_read8x8(tra + 8192 + 1024, r7, ktr);
        const u32x4v vfd = (u32x4v){pk2(bflo(vt[0]) * aD, bfhi(vt[0]) * aD), pk2(bflo(vt[1]) * aD, bfhi(vt[1]) * aD), 0u, 0u};
#pragma unroll
        for (int d = 0; d < 8; ++d) C[d] = mfma16((u32x4v){ktr[d][0], ktr[d][1], 0u, 0u}, vfd, C[d] * aC);
        }
        m = F15 + M15;
        }
        if (!sample) SEQ_STEP_END(j, nch, PW);
    }
#undef MSEQ_STAGE
#undef MSEQ_STAGE_TO
    {
        if (sample) acc_to_state_store(F, C, F.a->out + O_MCS + sidx * (HD * HD));
        else if (comp) { float* Co = F.a->out + (sample ? O_MCS : O_MCP) + sidx * (HD * HD) + 16 * et + c;
#pragma unroll
        for (int d = 0; d < 8; ++d)
#pragma unroll
            for (int r = 0; r < 4; ++r) Co[(16 * d + 4 * g + r) * HD] = C[d][r]; }
        if (nwave && c == 0) { float* no = F.a->out + (sample ? O_MNS : O_MNP) + sidx * HD;
#pragma unroll
            for (int d = 0; d < 8; ++d)
#pragma unroll
                for (int r = 0; r < 4; ++r) no[16 * d + 4 * g + r] = nrep[d][r]; }
        if (nwave && l == 0) F.a->out[(sample ? O_MMS : O_MMP) + sidx] = m;
    }
}
__device__ __forceinline__ void mlstm_nwalk(const Frame& F, int layer, int b, int h) {
    const int l = ((int)threadIdx.x & 63), c = l & 15, g = l >> 4;
    const bf16* proj = (const bf16*)(F.a->ws + WS_PROJ);
    const size_t sidx = (size_t)(layer * BATCH + b) * HA + h;
    const unsigned char* blob0 = F.a->ws + WS_BLOB_A + (size_t)((b * HA + h) * NCH_P) * BLOB_A;
    LAS unsigned char* base = F.lds + F.wave * 16384;
    f32x4 nrep[8]; float m = 0.f;
#pragma unroll
    for (int d = 0; d < 8; ++d) nrep[d] = (f32x4){0.f, 0.f, 0.f, 0.f};
#define NW_STAGE(j) do { LAS unsigned char* bufp_ = base + ((j) % 3) * 5120; \
        _Pragma("unroll") for (int pc_ = 0; pc_ < 4; ++pc_) { const int slot_ = 4 * pc_ + g; \
            __builtin_amdgcn_global_load_lds((const unsigned*)(proj + ((size_t)b * LP + (j) * 16 + slot_) * NP + C_AQ + h * HD + (c ^ ((slot_ & 7) << 1)) * 8), (LAS unsigned*)(bufp_ + pc_ * 1024), 16, 0, 0); } \
        __builtin_amdgcn_global_load_lds((const unsigned*)(blob0 + (size_t)(j) * BLOB_A + 5120 + l * 16), (LAS unsigned*)(bufp_ + 4096), 16, 0, 0); } while (0)
    NW_STAGE(0); NW_STAGE(1);
    float* dn_out = (float*)(F.a->ws + WS_GATES) + 24 + h;
    for (int j = 0; j < NCH_P; ++j) {
        if (j + 2 < NCH_P) { NW_STAGE(j + 2); asm volatile("s_waitcnt vmcnt(10)" ::: "memory"); }
        else if (j + 1 < NCH_P) asm volatile("s_waitcnt vmcnt(5)" ::: "memory");
        else asm volatile("s_waitcnt vmcnt(0)" ::: "memory");
        LAS unsigned char* buf = base + (j % 3) * 5120; LAS unsigned char* bt = buf + 4096;
        const f32x4 R4 = *(const LAS f32x4*)(bt + 512 + 16 * g), F4 = *(const LAS f32x4*)(bt + 576 + 16 * g), rs4 = *(const LAS f32x4*)(bt + 640 + 16 * g);
        const float R15 = *(const LAS float*)(bt + 512 + 60), F15 = *(const LAS float*)(bt + 576 + 60);
        const float M15 = fmaxf(m, R15), e15 = __expf(-fabsf(m - R15)), aC = m >= R15 ? 1.f : e15, aD = m >= R15 ? e15 : 1.f;
        f32x4 accn = (f32x4){0.f, 0.f, 0.f, 0.f};
#pragma unroll
        for (int kk = 0; kk < 4; ++kk) {
            const u32x2v q0 = *(const LAS u32x2v*)(buf + c * 256 + ((64 * kk + 8 * g) ^ ((c & 7) << 5))), q1 = *(const LAS u32x2v*)(buf + c * 256 + ((64 * kk + 32 + 8 * g) ^ ((c & 7) << 5)));
            const u32x4v nf = (u32x4v){pk2(nrep[2 * kk][0], nrep[2 * kk][1]), pk2(nrep[2 * kk][2], nrep[2 * kk][3]), pk2(nrep[2 * kk + 1][0], nrep[2 * kk + 1][1]), pk2(nrep[2 * kk + 1][2], nrep[2 * kk + 1][3])};
            accn = mfma16((u32x4v){q0[0], q0[1], q1[0], q1[1]}, nf, accn);
        }
#pragma unroll
        for (int r = 0; r < 4; ++r) { const float Mt = fmaxf(m, R4[r]), e = __expf(-fabsf(m - R4[r])), c1 = m >= R4[r] ? 1.f : e, c2 = m >= R4[r] ? e : 1.f;
            const float emt = __expf(fminf(-(F4[r] + Mt), 60.f)), den = c1 * accn[r] + c2 * rs4[r];
            if (c == 0) dn_out[((size_t)b * LP + j * 16 + 4 * g + r) * 32] = fmaxf(fabsf(den), emt); }
#pragma unroll
        for (int d = 0; d < 8; ++d) { const f32x4 dn4 = *(const LAS f32x4*)(bt + (16 * d + 4 * g) * 4); nrep[d] = nrep[d] * aC + dn4 * aD; }
        m = F15 + M15;
        asm volatile("s_waitcnt lgkmcnt(0)" ::: "memory");
    }
#undef NW_STAGE
    if (c == 0) { float* no = F.a->out + O_MNP + sidx * HD;
#pragma unroll
        for (int d = 0; d < 8; ++d)
#pragma unroll
            for (int r = 0; r < 4; ++r) no[16 * d + 4 * g + r] = nrep[d][r]; }
    if (l == 0) F.a->out[O_MMP + sidx] = m;
}
constexpr int BLOB_C = 10240;
constexpr int NSEQ_CP = BATCH * HC, NSEQ_CS = DB * HC;
static_assert(WS_BLOB_C + (size_t)(NSEQ_CP * NCH_P + NSEQ_CS) * BLOB_C <= WS_BLOB_B, "HGRN2 blobs");
__device__ __forceinline__ void hgrn_pre(const Frame& F, int layer, int sample, int b, int h, int chunk, unsigned char* blob) {
    const int l = ((int)threadIdx.x & 63), c = l & 15, g = l >> 4;
    const bf16* proj = (const bf16*)(F.a->ws + WS_PROJ);
    size_t row; const bool valid = slot_row(sample, b, chunk, c, row);
    const bf16* qp = proj + row * NP + C_CQ + h * HD + 4 * g; const bf16* fp = proj + row * NP + C_CF + h * HD + 4 * g;
    unsigned char* kimg = blob + 5120; float* Dp = (float*)(blob + 9216);
    u32x4v qf[4], kf[4];
#pragma unroll
    for (int kk = 0; kk < 4; ++kk)
#pragma unroll
        for (int hh = 0; hh < 2; ++hh) {
            const int d = 32 * kk + 16 * hh + 4 * g;
            const uint2 qw = *(const uint2*)(qp + 32 * kk + 16 * hh), fw = *(const uint2*)(fp + 32 * kk + 16 * hh);
            const float cq[4] = {bflo(qw.x), bfhi(qw.x), bflo(qw.y), bfhi(qw.y)}, cf[4] = {bflo(fw.x), bfhi(fw.x), bflo(fw.y), bfhi(fw.y)};
            float qt[4], kh[4], kt[4], D4[4];
#pragma unroll
            for (int i = 0; i < 4; ++i) { const int ch = h * HD + d + i;
                const float lb = layer == 0 ? 0.f : 1.0f / (1.0f + __expf(F.a->in[15][ch] - F.a->in[15][512 + ch]));
                const float sp = __builtin_amdgcn_rcpf(1.0f + __expf(-cf[i])), sn = __builtin_amdgcn_rcpf(1.0f + __expf(cf[i]));
                const float f = lb + (1.0f - lb) * sp;
                const float lg = valid ? __logf(f) : 0.f, kv = valid ? (1.0f - lb) * sn : 0.f, qv = valid ? siluf_(cq[i]) : 0.f;
                const float bt = row_cumsum16(lg), b15 = dpp_sum16(lg);
                qt[i] = qv * __expf(bt); kh[i] = kv * __expf(fminf(-bt, 80.f)); kt[i] = kv * __expf(b15 - bt); D4[i] = __expf(b15); }
            const unsigned q0 = pk2(qt[0], qt[1]), q1 = pk2(qt[2], qt[3]), k0 = pk2(kh[0], kh[1]), k1 = pk2(kh[2], kh[3]);
            if (hh == 0) { qf[kk][0] = q0; qf[kk][1] = q1; kf[kk][0] = k0; kf[kk][1] = k1; } else { qf[kk][2] = q0; qf[kk][3] = q1; kf[kk][2] = k0; kf[kk][3] = k1; }
            *(uint2*)(kimg + c * 256 + ((d * 2) ^ ((c & 7) << 5))) = make_uint2(pk2(kt[0], kt[1]), pk2(kt[2], kt[3]));
            if (c == 0) *(f32x4*)(Dp + d) = (f32x4){D4[0], D4[1], D4[2], D4[3]};
        }
    f32x4 at = (f32x4){0.f, 0.f, 0.f, 0.f};
#pragma unroll
    for (int kk = 0; kk < 4; ++kk) at = mfma16(kf[kk], qf[kk], at);
    float P[4];
#pragma unroll
    for (int r = 0; r < 4; ++r) P[r] = (4 * g + r <= c) ? at[r] : 0.f;
    *(u32x4v*)(blob + l * 16) = (u32x4v){pk2(P[0], P[1]), pk2(P[2], P[3]), 0u, 0u};
#pragma unroll
    for (int kk = 0; kk < 4; ++kk) *(u32x4v*)(blob + 1024 + kk * 1024 + l * 16) = qf[kk];
}
constexpr int SQC_BUF = 14336;
__device__ __forceinline__ void hgrn_seq(const Frame& F, int layer, int sample, int b, int h, int half, const Pref pf) {
    const int l = ((int)threadIdx.x & 63), c = l & 15, g = l >> 4, w = F.wave;
    const bool split = half >= 0; const int et = split ? half * 4 + (w & 3) : w; const bool comp = !split || w < 4; const int lw = split ? w - 4 : w, nl = split ? 4 : 8;
    const bf16* proj = (const bf16*)(F.a->ws + WS_PROJ);
    const int nch = sample ? 1 : NCH_P;
    const size_t sidx = (size_t)(layer * (sample ? DB : BATCH) + b) * HC + h;
    const unsigned char* blob0 = F.a->ws + WS_BLOB_C + (size_t)(sample ? NSEQ_CP * NCH_P + b * HC + h : (b * HC + h) * NCH_P) * BLOB_C;
    f32x4 S[8];
#pragma unroll
    for (int d = 0; d < 8; ++d) S[d] = (f32x4){0.f, 0.f, 0.f, 0.f};
#define CSEQ_STAGE_TO(bi_, sb_, sh_, j, blobj_) do { LAS unsigned char* bufp_ = F.lds + (bi_) * SQC_BUF; \
        _Pragma("unroll") for (int pi_ = 0; pi_ < 4; ++pi_) { const int pc_ = lw + nl * pi_; if (lw >= 0 && pc_ < 14) { const unsigned char* src_; \
            if (pc_ < 4) { size_t row_; (void)slot_row(sample, (sb_), (j), 4 * pc_ + g, row_); src_ = (const unsigned char*)(proj + row_ * NP + C_CI + (sh_) * HD + (c ^ (((4 * pc_ + g) & 7) << 1)) * 8); } \
            else src_ = (blobj_) + (pc_ - 4) * 1024 + l * 16; \
            __builtin_amdgcn_global_load_lds((const unsigned*)src_, (LAS unsigned*)(bufp_ + pc_ * 1024), 16, 0, 0); } } } while (0)
#define CSEQ_STAGE(j) CSEQ_STAGE_TO((j) % SEQ_NB, b, h, (j), blob0 + (size_t)(j) * BLOB_C)
    if (sample) {
        if (!pf.pre) { __syncthreads(); state_dma(F, F.a->in[7] + sidx * (HD * HD)); CSEQ_STAGE_TO(pf.par, b, h, 0, blob0); }
        wait_vm(0); SEQ_SYNC();
        state_to_acc(F, S);
        SEQ_SYNC();
        if (pf.nxt) { const size_t nidx = (size_t)(layer * DB + pf.nb) * HC + pf.nh;
            state_dma(F, F.a->in[7] + nidx * (HD * HD)); CSEQ_STAGE_TO(pf.par ^ 1, pf.nb, pf.nh, 0, F.a->ws + WS_BLOB_C + (size_t)(NSEQ_CP * NCH_P + pf.nb * HC + pf.nh) * BLOB_C); }
    } else __syncthreads();
    const int PW = lw < 0 ? 0 : (14 - lw + nl - 1) / nl;
    if (!sample) SEQ_PROLOGUE(CSEQ_STAGE, nch, PW);
    for (int j = 0; j < nch; ++j) {
        if (!sample && j + SEQ_D < nch) CSEQ_STAGE(j + SEQ_D);
        if (comp) {
        LAS unsigned char* buf = F.lds + (sample ? pf.par : j % SEQ_NB) * SQC_BUF;
        const unsigned bufa = (unsigned)(size_t)buf;
        LAS unsigned char* bl = buf + 4096;
        f32x4 acc = (f32x4){0.f, 0.f, 0.f, 0.f};
#pragma unroll
        for (int kk = 0; kk < 4; ++kk) {
            const u32x4v qf = *(const LAS u32x4v*)(bl + 1024 + kk * 1024 + l * 16);
            const u32x4v sf = (u32x4v){pk2(S[2 * kk][0], S[2 * kk][1]), pk2(S[2 * kk][2], S[2 * kk][3]), pk2(S[2 * kk + 1][0], S[2 * kk + 1][1]), pk2(S[2 * kk + 1][2], S[2 * kk + 1][3])};
            acc = mfma16(sf, qf, acc);
        }
        const unsigned tra = bufa + (unsigned)((4 * g + (c >> 2)) * 256 + (c & 3) * 8), r7 = (unsigned)((4 * g + (c >> 2)) & 7);
        const u32x2v vt = tr_read8(tra + 32 * ((unsigned)et ^ r7));
        const u32x4v vf = (u32x4v){vt[0], vt[1], 0u, 0u};
        acc = mfma16(vf, *(const LAS u32x4v*)(bl + l * 16), acc);
        {
            bf16* hc = (bf16*)(F.a->ws + WS_HCAT);
            { size_t row; const bool valid = slot_row(sample, b, j, c, row);
                if (valid) *(uint2*)(hc + row * MIX + 1536 + h * HD + 16 * et + 4 * g) = make_uint2(pk2(acc[0], acc[1]), pk2(acc[2], acc[3])); }
        }
        u32x2v ktr[8]; tr_read8x8(tra + 4096 + 5120, r7, ktr);
#pragma unroll
        for (int d = 0; d < 8; ++d) {
            const u32x2v kt = ktr[d];
            const f32x4 D4 = *(const LAS f32x4*)(bl + 9216 + (16 * d + 4 * g) * 4);
            S[d] = mfma16((u32x4v){kt[0], kt[1], 0u, 0u}, vf, S[d] * D4);
        }
        }
        if (!sample) SEQ_STEP_END(j, nch, PW);
    }
#undef CSEQ_STAGE
#undef CSEQ_STAGE_TO
    {
        if (sample) acc_to_state_store(F, S, F.a->out + O_HSS + sidx * (HD * HD));
        else if (comp) { float* So = F.a->out + (sample ? O_HSS : O_HSP) + sidx * (HD * HD) + 16 * et + c;
#pragma unroll
        for (int d = 0; d < 8; ++d)
#pragma unroll
            for (int r = 0; r < 4; ++r) So[(16 * d + 4 * g + r) * HD] = S[d][r]; }
    }
}
constexpr int BLOB_B = 18432;
constexpr int NSEQ_BP = BATCH * HB, NSEQ_BS = DB * HB;
static_assert(WS_BLOB_B + (size_t)(NSEQ_BP * NCH_P + NSEQ_BS) * BLOB_B <= WS_END, "DeltaNet blobs");
__device__ __forceinline__ void gdn_conv4(const Frame& F, int layer, int sample, int b, size_t seqrow0, int tt, int ch, float (&o)[4]) {
    const bf16* proj = (const bf16*)(F.a->ws + WS_PROJ);
    float a0 = 0.f, a1 = 0.f, a2 = 0.f, a3 = 0.f;
#pragma unroll
    for (int j = 0; j < 4; ++j) { const int tau = tt - 3 + j; float u0, u1, u2, u3;
        if (tau >= 0) { const uint2 w = *(const uint2*)(proj + (seqrow0 + tau) * NP + C_BQ + ch); u0 = bflo(w.x); u1 = bfhi(w.x); u2 = bflo(w.y); u3 = bfhi(w.y); }
        else if (sample) { const f32x4 s = *(const f32x4*)(F.a->in[6] + ((size_t)(layer * DB + b) * 3 + (3 + tau)) * NCONV + ch); u0 = s[0]; u1 = s[1]; u2 = s[2]; u3 = s[3]; }
        else { u0 = 0.f; u1 = 0.f; u2 = 0.f; u3 = 0.f; }
        const f32x4 wv = *(const f32x4*)(F.a->in[14] + ((size_t)layer * 4 + j) * NCONV + ch);
        a0 += wv[0] * u0; a1 += wv[1] * u1; a2 += wv[2] * u2; a3 += wv[3] * u3; }
    o[0] = siluf_(a0); o[1] = siluf_(a1); o[2] = siluf_(a2); o[3] = siluf_(a3);
}
__device__ __forceinline__ u32x4v frag4(const f32x4 x) { return (u32x4v){pk2(x[0], x[1]), pk2(x[2], x[3]), 0u, 0u}; }
template <int SAMPLE>
__device__ __forceinline__ void gdn_conv_op(const Frame& F, int layer, int b, size_t seqrow0, int chunk, int c, int g, int h, const int op, const LAS float* wb, float (&out)[32]) {
    const bf16* proj = (const bf16*)(F.a->ws + WS_PROJ);
    const int chb = op * 768 + h * HD + 4 * g;
#define GDN_TAP(j, SHL, SHR) do { const f32x4 wv = *(const LAS f32x4*)(wb + ((j) * 3 + op) * 128 + 16 * p + 4 * g); f32x4 t; \
            _Pragma("unroll") for (int i = 0; i < 4; ++i) { const float oldv = SAMPLE ? 0.f : ((j) == 0 ? ex[q][i] : DPP_F(ex[q][i], SHL, 0.f, true));     \
                t[i] = DPP_F(mn[q][i], SHR, oldv, false); }                                                                                                  \
            acc += wv * t; } while (0)
#pragma unroll
    for (int hf = 0; hf < 2; ++hf) {
        f32x4 mn[4], ex[4];
        if (!SAMPLE) {
            const bf16* pm = proj + (seqrow0 + chunk * 16 + c) * NP + C_BQ + chb + 64 * hf;
            const bool he = chunk > 0 && c < 3;
            const bf16* pe = proj + (seqrow0 + (he ? chunk * 16 - 3 + c : 0)) * NP + C_BQ + chb + 64 * hf;
#pragma unroll
            for (int q = 0; q < 4; ++q) { const uint2 w = *(const uint2*)(pm + 16 * q); mn[q] = (f32x4){bflo(w.x), bfhi(w.x), bflo(w.y), bfhi(w.y)};
                uint2 e = *(const uint2*)(pe + 16 * q); if (!he) e = make_uint2(0u, 0u); ex[q] = (f32x4){bflo(e.x), bfhi(e.x), bflo(e.y), bfhi(e.y)}; }
        } else {
            const bool tk = c >= 8, st = c >= 5 && c < 8;
            const bf16* pm = proj + (seqrow0 + (tk ? c - 8 : 0)) * NP + C_BQ + chb + 64 * hf;
            const float* ps = F.a->in[6] + ((size_t)(layer * DB + b) * 3 + (st ? c - 5 : 0)) * NCONV + chb + 64 * hf;
#pragma unroll
            for (int q = 0; q < 4; ++q) { const uint2 w = *(const uint2*)(pm + 16 * q); const f32x4 sv = *(const f32x4*)(ps + 16 * q);
                const f32x4 mv = (f32x4){bflo(w.x), bfhi(w.x), bflo(w.y), bfhi(w.y)};
                mn[q] = tk ? mv : (st ? sv : (f32x4){0.f, 0.f, 0.f, 0.f}); ex[q] = (f32x4){0.f, 0.f, 0.f, 0.f}; }
        }
#pragma unroll
        for (int q = 0; q < 4; ++q) { const int p = 4 * hf + q;
            f32x4 acc = *(const LAS f32x4*)(wb + (3 * 3 + op) * 128 + 16 * p + 4 * g) * mn[q];
            GDN_TAP(0, 0x101, 0x113); GDN_TAP(1, 0x101, 0x112); GDN_TAP(2, 0x102, 0x111);
#pragma unroll
            for (int i = 0; i < 4; ++i) out[4 * p + i] = siluf_(acc[i]);
        }
        asm volatile("" ::: "memory");
    }
#undef GDN_TAP
}
template <int SAMPLE>
__device__ __forceinline__ void gdn_pre(const Frame& F, int layer, int b, int h, int chunk, unsigned char* blob) {
    constexpr int sample = SAMPLE;
    int l_ = ((int)threadIdx.x & 63); if (!SAMPLE) asm volatile("" : "+v"(l_));
    const int l = l_, c = l & 15, g = l >> 4;
    LAS unsigned char* scr = F.lds + F.wave * 16384;
    LAS float* wb = (LAS float*)(scr + 8192);
    const float* gates = (const float*)(F.a->ws + WS_GATES);
    size_t row; const bool valid = slot_row(sample, b, chunk, c, row);
    const size_t seqrow0 = sample ? (size_t)(MP_ROWS + b * DS) : (size_t)b * LP;
    const float vm = valid ? 1.f : 0.f;
#pragma unroll
    for (int k = 0; k < 6; ++k) { const int idx = l + 64 * k, j = idx / 96, rem = idx - j * 96, o = rem >> 5, d4 = rem & 31;
        *(LAS f32x4*)(wb + idx * 4) = *(const f32x4*)(F.a->in[14] + ((size_t)layer * 4 + j) * NCONV + o * 768 + h * HD + d4 * 4); }
    const float gval = valid ? -__expf(F.a->in[12][layer * HB + h]) * softplusf_(gates[row * 32 + 12 + h] + F.a->in[13][layer * HB + h]) : 0.f;
    const float beta = valid ? sigmoidf_(gates[row * 32 + 18 + h]) : 0.f;
    const float G = row_cumsum16(gval), G15 = dpp_sum16(gval);
    const float eG = __expf(G), eK = __expf(G15 - G);
    u32x4v kf[4], qf[4];
    {
        float v[32]; gdn_conv_op<SAMPLE>(F, layer, b, seqrow0, chunk, c, g, h, 2, wb, v);
#pragma unroll
        for (int p = 0; p < 8; ++p) { const int d = 16 * p + 4 * g;
            *(LAS u32x2v*)(scr + 4096 + c * 256 + ((d * 2) ^ ((c & 7) << 5))) = (u32x2v){pk2(v[4 * p] * vm, v[4 * p + 1] * vm), pk2(v[4 * p + 2] * vm, v[4 * p + 3] * vm)}; }
    }
    {
        float kv[32]; gdn_conv_op<SAMPLE>(F, layer, b, seqrow0, chunk, c, g, h, 1, wb, kv);
        float ss = 0.f;
#pragma unroll
        for (int i = 0; i < 32; ++i) ss += kv[i] * kv[i];
        ss += __shfl_xor(ss, 16); ss += __shfl_xor(ss, 32);
        const float rk = rsqrtf(ss + 1e-6f) * vm;
        unsigned char* kimg = blob + 9216;
#pragma unroll
        for (int p = 0; p < 8; ++p) { const int kk = p >> 1, hh = p & 1, d = 16 * p + 4 * g;
            const float k0 = kv[4 * p] * rk, k1 = kv[4 * p + 1] * rk, k2 = kv[4 * p + 2] * rk, k3 = kv[4 * p + 3] * rk;
            const unsigned w0 = pk2(k0, k1), w1 = pk2(k2, k3);
            if (hh == 0) { kf[kk][0] = w0; kf[kk][1] = w1; } else { kf[kk][2] = w0; kf[kk][3] = w1; }
            *(LAS u32x2v*)(scr + c * 256 + ((d * 2) ^ ((c & 7) << 5))) = (u32x2v){w0, w1};
            *(uint2*)(kimg + c * 256 + ((d * 2) ^ ((c & 7) << 5))) = make_uint2(pk2(k0 * eK, k1 * eK), pk2(k2 * eK, k3 * eK)); }
    }
    {
        float qv[32]; gdn_conv_op<SAMPLE>(F, layer, b, seqrow0, chunk, c, g, h, 0, wb, qv);
        float ss = 0.f;
#pragma unroll
        for (int i = 0; i < 32; ++i) ss += qv[i] * qv[i];
        ss += __shfl_xor(ss, 16); ss += __shfl_xor(ss, 32);
        const float rq = rsqrtf(ss + 1e-6f) * 0.08838834764831845f * vm, rg = rq * eG;
#pragma unroll
        for (int kk = 0; kk < 4; ++kk) { const int o = 8 * kk;
            qf[kk] = (u32x4v){pk2(qv[o] * rq, qv[o + 1] * rq), pk2(qv[o + 2] * rq, qv[o + 3] * rq), pk2(qv[o + 4] * rq, qv[o + 5] * rq), pk2(qv[o + 6] * rq, qv[o + 7] * rq)};
            *(u32x4v*)(blob + 1024 + kk * 1024 + l * 16) = (u32x4v){pk2(qv[o] * rg, qv[o + 1] * rg), pk2(qv[o + 2] * rg, qv[o + 3] * rg), pk2(qv[o + 4] * rg, qv[o + 5] * rg), pk2(qv[o + 6] * rg, qv[o + 7] * rg)}; }
    }
    const f32x4 z4 = (f32x4){0.f, 0.f, 0.f, 0.f};
    f32x4 KK = z4, KQ = z4;
#pragma unroll
    for (int kk = 0; kk < 4; ++kk) { KK = mfma16(kf[kk], kf[kk], KK); KQ = mfma16(kf[kk], qf[kk], KQ); }
    f32x4 Aqk, LRn, LCn, Id, bs, eGs;
#pragma unroll
    for (int r = 0; r < 4; ++r) { const int s = 4 * g + r; const float Gs = __shfl(G, (l & 48) | s); bs[r] = __shfl(beta, (l & 48) | s);
        eGs[r] = __expf(Gs);
        Aqk[r] = (s <= c) ? __expf(G - Gs) * KQ[r] : 0.f;
        LRn[r] = (s < c) ? beta * __expf(G - Gs) * KK[r] : 0.f;
        LCn[r] = (c < s) ? bs[r] * __expf(Gs - G) * KK[r] : 0.f;
        Id[r] = (s == c) ? 1.f : 0.f; }
    *(u32x4v*)(blob + l * 16) = frag4(Aqk);
    const f32x4 LC2 = mfma16(frag4(LRn), frag4(LCn), z4), LR2 = mfma16(frag4(LCn), frag4(LRn), z4);
    const f32x4 LC4 = mfma16(frag4(LR2), frag4(LC2), z4), LR4 = mfma16(frag4(LC2), frag4(LR2), z4);
    const f32x4 LC8 = mfma16(frag4(LR4), frag4(LC4), z4);
    const f32x4 LRp1 = mfma16(frag4(Id + LC2), frag4(Id - LRn), z4);
    const f32x4 LRp2 = mfma16(frag4(Id + LC4), frag4(LRp1), z4);
    const f32x4 LRt = mfma16(frag4(Id + LC8), frag4(LRp2), z4);
    const u32x4v TU = frag4(LRt * bs), TW = frag4(LRt * bs * eGs);
    const unsigned tra = (unsigned)(size_t)scr + (unsigned)((4 * g + (c >> 2)) * 256 + (c & 3) * 8), r7 = (unsigned)((4 * g + (c >> 2)) & 7);
    u32x2v vtr[8], ktr[8]; tr_read8x8(tra + 4096, r7, vtr); tr_read8x8(tra, r7, ktr);
#pragma unroll
    for (int e = 0; e < 8; ++e) { const u32x2v vt = vtr[e];
        const f32x4 U = mfma16(TU, (u32x4v){vt[0], vt[1], 0u, 0u}, z4);
        *(uint2*)(blob + 13312 + e * 512 + l * 8) = make_uint2(pk2(U[0], U[1]), pk2(U[2], U[3])); }
#pragma unroll
    for (int kk = 0; kk < 4; ++kk) { const u32x2v k0 = ktr[2 * kk], k1 = ktr[2 * kk + 1];
        const f32x4 W0 = mfma16((u32x4v){k0[0], k0[1], 0u, 0u}, TW, z4), W1 = mfma16((u32x4v){k1[0], k1[1], 0u, 0u}, TW, z4);
        *(u32x4v*)(blob + 5120 + kk * 1024 + l * 16) = (u32x4v){pk2(-W0[0], -W0[1]), pk2(-W0[2], -W0[3]), pk2(-W1[0], -W1[1]), pk2(-W1[2], -W1[3])}; }
    if (l == 0) *(float*)(blob + 17408) = __expf(G15);
}
__device__ __forceinline__ void gdn_seq(const Frame& F, int layer, int sample, int b, int h, int half, const Pref pf) {
    const int l = ((int)threadIdx.x & 63), c = l & 15, g = l >> 4, w = F.wave;
    const bool split = half >= 0; const int et = split ? half * 4 + (w & 3) : w; const bool comp = !split || w < 4; const int lw = split ? w - 4 : w, nl = split ? 4 : 8;
    const int nch = sample ? 1 : NCH_P;
    const size_t sidx = (size_t)(layer * (sample ? DB : BATCH) + b) * HB + h;
    const unsigned char* blob0 = F.a->ws + WS_BLOB_B + (size_t)(sample ? NSEQ_BP * NCH_P + b * HB + h : (b * HB + h) * NCH_P) * BLOB_B;
    f32x4 S[8];
#pragma unroll
    for (int d = 0; d < 8; ++d) S[d] = (f32x4){0.f, 0.f, 0.f, 0.f};
#define BSEQ_STAGE_TO(bi_, blobj_) do { LAS unsigned char* bufp_ = F.lds + (bi_) * BLOB_B; \
        _Pragma("unroll") for (int pi_ = 0; pi_ < 5; ++pi_) { const int pc_ = lw + nl * pi_; if (lw >= 0 && pc_ < 18) \
            __builtin_amdgcn_global_load_lds((const unsigned*)((blobj_) + pc_ * 1024 + l * 16), (LAS unsigned*)(bufp_ + pc_ * 1024), 16, 0, 0); } } while (0)
#define BSEQ_STAGE(j) BSEQ_STAGE_TO((j) % SEQ_NB, blob0 + (size_t)(j) * BLOB_B)
    if (sample) {
        if (!pf.pre) { __syncthreads(); state_dma(F, F.a->in[5] + sidx * (HD * HD)); BSEQ_STAGE_TO(pf.par, blob0); }
        wait_vm(0); SEQ_SYNC();
        state_to_acc(F, S);
        SEQ_SYNC();
        if (pf.nxt) { const size_t nidx = (size_t)(layer * DB + pf.nb) * HB + pf.nh;
            state_dma(F, F.a->in[5] + nidx * (HD * HD)); BSEQ_STAGE_TO(pf.par ^ 1, F.a->ws + WS_BLOB_B + (size_t)(NSEQ_BP * NCH_P + pf.nb * HB + pf.nh) * BLOB_B); }
    } else __syncthreads();
    const int PW = lw < 0 ? 0 : (18 - lw + nl - 1) / nl;
    if (!sample) SEQ_PROLOGUE(BSEQ_STAGE, nch, PW);
    for (int j = 0; j < nch; ++j) {
        if (!sample && j + SEQ_D < nch) BSEQ_STAGE(j + SEQ_D);
        if (comp) {
        LAS unsigned char* bl = F.lds + (sample ? pf.par : j % SEQ_NB) * BLOB_B;
        const unsigned tra = (unsigned)(size_t)bl + (unsigned)((4 * g + (c >> 2)) * 256 + (c & 3) * 8), r7 = (unsigned)((4 * g + (c >> 2)) & 7);
        const u32x2v uw = *(const LAS u32x2v*)(bl + 13312 + et * 512 + l * 8);
        f32x4 Wacc = (f32x4){bflo(uw[0]), bfhi(uw[0]), bflo(uw[1]), bfhi(uw[1])}, oacc = (f32x4){0.f, 0.f, 0.f, 0.f};
#pragma unroll
        for (int kk = 0; kk < 4; ++kk) {
            const u32x4v sf = (u32x4v){pk2(S[2 * kk][0], S[2 * kk][1]), pk2(S[2 * kk][2], S[2 * kk][3]), pk2(S[2 * kk + 1][0], S[2 * kk + 1][1]), pk2(S[2 * kk + 1][2], S[2 * kk + 1][3])};
            Wacc = mfma16(*(const LAS u32x4v*)(bl + 5120 + kk * 1024 + l * 16), sf, Wacc);
            oacc = mfma16(sf, *(const LAS u32x4v*)(bl + 1024 + kk * 1024 + l * 16), oacc);
        }
        const u32x4v wf = frag4(Wacc);
        oacc = mfma16(wf, *(const LAS u32x4v*)(bl + l * 16), oacc);
        {
            bf16* hc = (bf16*)(F.a->ws + WS_HCAT);
            { size_t row; const bool valid = slot_row(sample, b, j, c, row);
                if (valid) *(uint2*)(hc + row * MIX + 768 + h * HD + 16 * et + 4 * g) = make_uint2(pk2(oacc[0], oacc[1]), pk2(oacc[2], oacc[3])); }
        }
        const float eG15 = *(const LAS float*)(bl + 17408);
        u32x2v ktr[8]; tr_read8x8(tra + 9216, r7, ktr);
#pragma unroll
        for (int d = 0; d < 8; ++d) {
            const u32x2v kt = ktr[d];
            S[d] = mfma16((u32x4v){kt[0], kt[1], 0u, 0u}, wf, S[d] * eG15);
        }
        }
        if (!sample) SEQ_STEP_END(j, nch, PW);
    }
#undef BSEQ_STAGE
#undef BSEQ_STAGE_TO
    {
        if (sample) acc_to_state_store(F, S, F.a->out + O_GSS + sidx * (HD * HD));
        else if (comp) { float* So = F.a->out + (sample ? O_GSS : O_GSP) + sidx * (HD * HD) + 16 * et + c;
#pragma unroll
        for (int d = 0; d < 8; ++d)
#pragma unroll
            for (int r = 0; r < 4; ++r) So[(16 * d + 4 * g + r) * HD] = S[d][r]; }
    }
}
__device__ __forceinline__ void pre_mixers(const Frame& F, int layer) {
    const int gw_ = F.vb * NWAVES + F.wave, nw_ = F.G * NWAVES;
#define PRE_LOOP(off, n, it) int PRE_CAT(o_, __LINE__) = (off); while (PRE_CAT(o_, __LINE__) >= nw_) PRE_CAT(o_, __LINE__) -= nw_;        \
    for (int it = gw_ - PRE_CAT(o_, __LINE__) + (gw_ < PRE_CAT(o_, __LINE__) ? nw_ : 0); it < (n); it += nw_)
#define PRE_CAT(a, b) PRE_CAT2(a, b)
#define PRE_CAT2(a, b) a##b
    constexpr int n0 = NSEQ_BP * NCH_P, n1 = NSEQ_BS, n2 = NSEQ_AP * NCH_P, n3 = NSEQ_AS, n4 = NSEQ_CP * NCH_P, n5 = NSEQ_CS;
    PRE_LOOP(0, n0, it) { const int seq = it / NCH_P, ch = it - seq * NCH_P; gdn_pre<0>(F, layer, seq / HB, seq % HB, ch, F.a->ws + WS_BLOB_B + (size_t)it * BLOB_B); }
    PRE_LOOP(n0, n1, it) gdn_pre<1>(F, layer, it / HB, it % HB, 0, F.a->ws + WS_BLOB_B + (size_t)(NSEQ_BP * NCH_P + it) * BLOB_B);
    PRE_LOOP(n0 + n1, n2, it) { const int seq = it / NCH_P, ch = it - seq * NCH_P; mlstm_pre(F, layer, 0, seq / HA, seq % HA, ch, F.a->ws + WS_BLOB_A + (size_t)it * BLOB_A); }
    PRE_LOOP(n0 + n1 + n2, n3, it) mlstm_pre(F, layer, 1, it / HA, it % HA, 0, F.a->ws + WS_BLOB_A + (size_t)(NSEQ_AP * NCH_P + it) * BLOB_A);
    PRE_LOOP(n0 + n1 + n2 + n3, n4, it) { const int seq = it / NCH_P, ch = it - seq * NCH_P; hgrn_pre(F, layer, 0, seq / HC, seq % HC, ch, F.a->ws + WS_BLOB_C + (size_t)it * BLOB_C); }
    PRE_LOOP(n0 + n1 + n2 + n3 + n4, n5, it) hgrn_pre(F, layer, 1, it / HC, it % HC, 0, F.a->ws + WS_BLOB_C + (size_t)(NSEQ_CP * NCH_P + it) * BLOB_C);
#undef PRE_LOOP
#undef PRE_CAT
#undef PRE_CAT2
}
__device__ __forceinline__ void pc_mixers(const Frame& F, int layer) {
    for (int i = F.vb * 512 + ((int)threadIdx.x); i < (BATCH + DB) * 3 * NCONV; i += F.G * 512) {
        const int ch = i % NCONV, j = (i / NCONV) % 3, bb = i / (3 * NCONV);
        if (bb < BATCH) F.a->out[O_GCP + ((size_t)(layer * BATCH + bb) * 3 + j) * NCONV + ch] = bf2f(((const bf16*)(F.a->ws + WS_PROJ))[((size_t)bb * LP + (LP - 3) + j) * NP + C_BQ + ch]);
        else { const int b = bb - BATCH; F.a->out[O_GCS + ((size_t)(layer * DB + b) * 3 + j) * NCONV + ch] = bf2f(((const bf16*)(F.a->ws + WS_PROJ))[((size_t)MP_ROWS + b * DS + (DS - 3) + j) * NP + C_BQ + ch]); }
    }
#define ITEM_LOOP(base, n, I) int I = F.vb; while (I < (base)) I += F.G; for (I -= (base); I < (n); I += F.G)
    const Pref nopf = {0, 0, 0, 0, 0};
    if (F.vb >= F.G - 3) { __syncthreads(); const int it = (F.vb - (F.G - 3)) * NWAVES + F.wave; if (it < NSEQ_AP) mlstm_nwalk(F, layer, it / HA, it % HA); __syncthreads(); }
    { ITEM_LOOP(0, 48, it) { const int sq = it >> 1; gdn_seq(F, layer, 0, sq / HB, sq % HB, it & 1, nopf); } }
    { ITEM_LOOP(48, 48, it) { const int sq = it >> 1; mlstm_seq(F, layer, 0, sq / HA, sq % HA, it & 1, nopf); } }
    { ITEM_LOOP(96, 32, it) { const int sq = it >> 1; hgrn_seq(F, layer, 0, sq / HC, sq % HC, it & 1, nopf); } }
    {
        gu32* qc = (gu32*)(F.a->ws + WS_CTL) + 8192 + layer * 64;
        volatile LAS int* slot = (volatile LAS int*)(F.lds + LDSCTL_OFF + 16);
        const Pref pf0 = {0, 0, 0, 0, 0};
#define QUEUE_NEXT(kind, I) do { __syncthreads(); if (F.tid == 0) *slot = (int)__hip_atomic_fetch_add(qc + 16 * (kind), 1u, __ATOMIC_RELAXED, __HIP_MEMORY_SCOPE_AGENT); __syncthreads(); I = *slot; } while (0)
        {
            constexpr int nmain = (MPAD / 256) * (NMAIN / 256), ndef = (MPAD / 256) * (NDEF / 256); const int r_ = nmain % F.G, nin_ = r_ ? F.G - r_ : 0;
            pg8::Gemm gd{((bf16*)(F.a->ws + WS_A)), ((bf16*)(F.a->ws + WS_WIN)) + ((size_t)layer * NPG + NMAIN) * DM, MPAD, NDEF, DM};
            pg8::EpiBf16 Ed{((bf16*)(F.a->ws + WS_PROJ)), NP, nullptr, -1, 3, 9, 24};
            int u; QUEUE_NEXT(3, u);
            constexpr int NPAIR = 120;
            for (;;) { const int u0_ = nin_ + (u < NPAIR ? 2 * u : NPAIR + u), u1_ = u0_ + (u < NPAIR ? 2 : 1); if (u0_ >= ndef) break;
                pg8::DefOrder D{u0_, u1_ < ndef ? u1_ : ndef, 1, 0, MPAD / 256}; pg8::gemm_phase<pg8::EpiBf16, pg8::DefOrder, true, true>(F.lds, gd, D, Ed); QUEUE_NEXT(3, u); }
        }
        { int it; QUEUE_NEXT(0, it); while (it < DB * HB) { gdn_seq(F, layer, 1, it / HB, it % HB, -1, pf0); QUEUE_NEXT(0, it); } }
        { int it; QUEUE_NEXT(1, it); while (it < DB * HA) { mlstm_seq(F, layer, 1, it / HA, it % HA, -1, pf0); QUEUE_NEXT(1, it); } }
        { int it; QUEUE_NEXT(2, it); while (it < DB * HC) { hgrn_seq(F, layer, 1, it / HC, it % HC, -1, pf0); QUEUE_NEXT(2, it); } }
#undef QUEUE_NEXT
    }
#undef ITEM_LOOP
}
constexpr int N_PHASES = 13;
__global__ void __launch_bounds__(NWAVES * 64, 2) hymba_fwd(Args args) {
    extern __shared__ __attribute__((aligned(16))) unsigned char lds[];
    Frame F;
    F.lds = (LAS unsigned char*)lds; F.a = &args;
    F.tid = threadIdx.x; F.lane = ((int)threadIdx.x) & 63; F.wave = __builtin_amdgcn_readfirstlane(((int)threadIdx.x) >> 6);
    F.G = gridDim.x; F.vb = blockIdx.x;
    gu32* ctl = (gu32*)(args.ws + WS_CTL);
    volatile LAS unsigned* MISC = (volatile LAS unsigned*)(F.lds + MISC_OFF);
    for (int u = ((int)threadIdx.x); u < (LDS_BYTES - LDSCTL_OFF) / 4; u += NWAVES * 64) ((LAS unsigned*)(F.lds + LDSCTL_OFF))[u] = 0u;
    __syncthreads();
    XcdBarrier bar; bar.bar = (unsigned*)(ctl + CW_BAR); bar.x = 0; bar.st = nullptr;
    const int lo = args.ph_lo, hi = args.ph_hi;
    if (hi - lo > 1) bar = xcd_barrier_post((unsigned*)(ctl + CW_BAR), MISC + 8);
#define IN(k) (lo <= (k) && (k) < hi)
#define SEAM(k) do { if (IN(k) && IN((k) + 1)) xcd_barrier(bar); } while (0)
    if (IN(0)) p0_convert(F, 0, F.vb, F.G, 0, 4480);
#define LAYER(layer) do { constexpr int pb = 1 + 6 * (layer); \
        if ((layer) == 0) { if (IN(pb - 1)) pa_norm(F, 0); SEAM(pb - 1); }        \
        if (IN(pb)) { \
              \
            constexpr int nmain = (MPAD / 256) * (NMAIN / 256); const int r_ = nmain % F.G, nin_ = r_ ? F.G - r_ : 0; \
            pg8::Gemm g{((bf16*)(args.ws + WS_A)), ((bf16*)(args.ws + WS_WIN)) + (size_t)(layer) * NPG * DM, MPAD, NPG, DM}; \
            pg8::MainDefOrder S; S.S.init(MPAD, NMAIN, F.G, (int)blockIdx.x); { const int c_ = (int)blockIdx.x, dl_ = c_ - r_; S.nm = (nmain - c_ + F.G - 1) / F.G; const bool hd_ = dl_ >= 0 && dl_ < nin_; \
              S.dpn = hd_ ? NMAIN / 256 + dl_ / (MPAD / 256) : -1; S.dpm = hd_ ? dl_ % (MPAD / 256) : 0; } \
            pg8::EpiBf16U E{((bf16*)(args.ws + WS_PROJ)), NP, (float*)(args.ws + WS_GATES)}; \
            pg8::gemm_phase<pg8::EpiBf16U, pg8::MainDefOrder, true, true>(F.lds, g, S, E); \
        } \
        SEAM(pb); \
        if (IN(pb + 1)) pre_mixers(F, (layer)); \
        SEAM(pb + 1); \
        if (IN(pb + 2)) { if ((layer) == 0 && F.vb >= 128) { p0_convert(F, 0, F.vb - 128, F.G - 128, 4480, 4480 + 1024); __syncthreads(); }     \
            pc_mixers(F, (layer)); } \
        SEAM(pb + 2); \
        if (IN(pb + 3)) pdg_phase(F, (layer));        \
        if ((layer) == 0) SEAM(pb + 4); } while (0)
    LAYER(0);
    LAYER(1);
}

extern "C" void kernel_launch(void* const* d_in, const int* in_sizes, int n_in, void* d_out, int out_size, void* d_ws, size_t ws_size, hipStream_t stream) {
    static int grid = 0;
    if (grid == 0) {
        if (n_in != 19 || (size_t)out_size != O_END || ws_size < WS_END) { fprintf(stderr, "kernel_launch: unexpected sizes: n_in %d out %d ws %zu (need 19, %zu, >= %zu)\n", n_in, out_size, ws_size, (size_t)O_END, (size_t)WS_END); grid = -1; return; }
        int dev = 0, cus = 0, per_cu = 0;
        if (hipGetDevice(&dev) != hipSuccess || hipDeviceGetAttribute(&cus, hipDeviceAttributeMultiprocessorCount, dev) != hipSuccess) { grid = -1; return; }
        if (hipFuncSetAttribute((const void*)hymba_fwd, hipFuncAttributeMaxDynamicSharedMemorySize, LDS_BYTES) != hipSuccess) { fprintf(stderr, "kernel_launch: hipFuncSetAttribute failed\n"); grid = -1; return; }
        if (hipOccupancyMaxActiveBlocksPerMultiprocessor(&per_cu, (const void*)hymba_fwd, NWAVES * 64, LDS_BYTES) != hipSuccess || per_cu < 1)
            fprintf(stderr, "kernel_launch: note: occupancy query reports %d workgroups per CU\n", per_cu);
        (void)hipGetLastError();
        grid = cus;
    }
    if (grid < 0) return;
    if (hipMemsetAsync((char*)d_ws + WS_CTL, 0, CTL_ZERO_BYTES, stream) != hipSuccess) { fprintf(stderr, "kernel_launch: memset failed\n"); return; }
    Args a{};
    for (int i = 0; i < 19; ++i) a.in[i] = (const float*)d_in[i];
    a.out = (float*)d_out; a.ws = (unsigned char*)d_ws;
#if MK_PER_PHASE
    for (int p = 0; p < N_PHASES; ++p) { a.ph_lo = p; a.ph_hi = p + 1; hipLaunchKernelGGL(hymba_fwd, dim3(grid), dim3(NWAVES * 64), LDS_BYTES, stream, a); }
#else
    a.ph_lo = 0; a.ph_hi = N_PHASES;
    hipLaunchKernelGGL(hymba_fwd, dim3(grid), dim3(NWAVES * 64), LDS_BYTES, stream, a);
#endif
    const hipError_t le = hipPeekAtLastError();
    if (le != hipSuccess) fprintf(stderr, "kernel_launch: launch failed: %s\n", hipGetErrorName(le));
}
```
